# Optimizing an MI355X kernel written in HIP

```python
import functools
import jax, jax.numpy as jnp
from jax import lax
import numpy as np

D_MODEL = 2048
BATCH = 4
SEQ = 4096
DEPTH = 2

GRID_W = 64
CTX_LEN = 256
N_EVEN = (DEPTH + 1) // 2
N_ODD = DEPTH // 2
N_MOD = 6
EPS = 1e-6

POOL_WINDOWS = (2, 4, 8, 16)
POOL_GROUPS = 4
D_POOL = D_MODEL // 2
POOL_GROUP_DIM = D_POOL // POOL_GROUPS
D_CONV = D_MODEL // 2
CONV_WIDTH = 31
D_IN_EVEN = D_POOL + 2 * D_CONV
D_MIX_EVEN = D_POOL + D_CONV

MLA_HEADS = 8
Q_LORA = 512
KV_LORA = 512
QK_NOPE = 128
QK_ROPE = 64
V_HEAD = 128
ROPE_FREQS = QK_ROPE // 4
ROPE_THETA = 10000.0
SM_SCALE = (QK_NOPE + QK_ROPE) ** -0.5
Q_BLOCK = 128
SGU_HEADS = 8
D_SGU = D_MODEL // 2
SGU_HEAD_DIM = D_SGU // SGU_HEADS
CHUNK = 128
COL_Q = Q_LORA
COL_KV = Q_LORA + KV_LORA
COL_KR = Q_LORA + KV_LORA + QK_ROPE
COL_U = COL_KR + D_SGU
D_IN_ODD = COL_U + D_SGU
D_MIX_ODD = MLA_HEADS * V_HEAD + D_SGU

D_FF = 5632
N_EXPERTS = 8
TOP_K = 2
D_FF_EXPERT = 7168

kernel_name = "hybrid_pool_conv_mla_sgu_moe_dit"


def rmsnorm(x, g):
    xf = x.astype(jnp.float32)
    y = xf * lax.rsqrt(jnp.mean(xf * xf, axis=-1, keepdims=True) + EPS)
    return (y * g.astype(jnp.float32)).astype(x.dtype)


def layernorm(x, g, b):
    xf = x.astype(jnp.float32)
    mu = jnp.mean(xf, axis=-1, keepdims=True)
    var = jnp.mean(jnp.square(xf - mu), axis=-1, keepdims=True)
    y = (xf - mu) * lax.rsqrt(var + EPS)
    return (y * g.astype(jnp.float32) + b.astype(jnp.float32)).astype(x.dtype)


def ada_params(cond, w, b):
    m = jnp.matmul(jax.nn.silu(cond), w) + b
    return jnp.split(m[..., None, :], N_MOD, axis=-1)


def modulate(h, shift, scale):
    return h * (1 + scale) + shift


def swiglu(h, w_gate, w_up, w_down):
    return jnp.matmul(jax.nn.silu(jnp.matmul(h, w_gate)) * jnp.matmul(h, w_up), w_down)


def moe_swiglu(h, router_w, router_b, w_gate, w_up, w_down):
    logits = (jnp.matmul(h, router_w) + router_b).astype(jnp.float32)
    top_v, top_i = lax.top_k(logits, TOP_K)
    top_p = jax.nn.softmax(top_v, axis=-1)
    gates = jnp.sum(jax.nn.one_hot(top_i, N_EXPERTS, dtype=jnp.float32) * top_p[..., None], axis=-2).astype(h.dtype)
    y = jnp.zeros_like(h)
    for e in range(N_EXPERTS):
        y = y + gates[..., e:e + 1] * swiglu(h, w_gate[e], w_up[e], w_down[e])
    return y


def multiscale_pool(u, pool_w, pool_scale):
    b_, l_, _ = u.shape
    uf = u.astype(jnp.float32)
    csum = jnp.concatenate([jnp.zeros_like(uf[:, :1]), jnp.cumsum(uf, axis=1)], axis=1)
    t = jnp.arange(l_)
    outs = []
    for g, w in enumerate(POOL_WINDOWS):
        lo = jnp.clip(t - w // 2, 0, l_)
        hi = jnp.clip(t - w // 2 + w, 0, l_)
        seg = csum[:, :, g * POOL_GROUP_DIM:(g + 1) * POOL_GROUP_DIM]
        s = jnp.take(seg, hi, axis=1) - jnp.take(seg, lo, axis=1)
        outs.append(s / (hi - lo).astype(jnp.float32)[None, :, None])
    pooled = jnp.concatenate(outs, axis=-1).astype(u.dtype) - u
    pooled = pooled.reshape(b_, l_, POOL_GROUPS, POOL_GROUP_DIM)
    mixed = jnp.einsum('blgc,gcd->blgd', pooled, pool_w).reshape(b_, l_, D_POOL)
    return mixed * pool_scale


def conformer_conv(a, gate, conv_w, conv_b, ln_g, ln_b):
    z = a * jax.nn.sigmoid(gate)
    z = lax.conv_general_dilated(z, conv_w[:, None, :], window_strides=(1,),
                                 padding=[(CONV_WIDTH // 2, CONV_WIDTH // 2)],
                                 dimension_numbers=('NWC', 'WIO', 'NWC'),
                                 feature_group_count=D_CONV) + conv_b
    return jax.nn.silu(layernorm(z, ln_g, ln_b))


def pool_conv_mixer(h, w_in, pool_w, pool_scale, conv_w, conv_b, ln_g, ln_b, w_out):
    p = jnp.matmul(h, w_in)
    u, a, g = jnp.split(p, [D_POOL, D_POOL + D_CONV], axis=-1)
    y = jnp.concatenate([multiscale_pool(u, pool_w, pool_scale),
                         conformer_conv(a, g, conv_w, conv_b, ln_g, ln_b)], axis=-1)
    return jnp.matmul(y, w_out)


def rope_tables(l_):
    rows = l_ // GRID_W
    row = jnp.repeat(jnp.arange(rows), GRID_W).astype(jnp.float32)
    col = jnp.tile(jnp.arange(GRID_W), rows).astype(jnp.float32)
    inv = ROPE_THETA ** (-jnp.arange(ROPE_FREQS, dtype=jnp.float32) / ROPE_FREQS)
    ang = jnp.stack([row[:, None] * inv, col[:, None] * inv], axis=1)
    return jnp.cos(ang), jnp.sin(ang)


def apply_rope_2d(x, cos, sin):
    shp = x.shape
    xr = x.reshape(shp[:-1] + (2, 2, ROPE_FREQS)).astype(jnp.float32)
    x1, x2 = xr[..., 0, :], xr[..., 1, :]
    out = jnp.stack([x1 * cos - x2 * sin, x2 * cos + x1 * sin], axis=-2)
    return out.reshape(shp).astype(x.dtype)


def mla_q(cq, q_norm_g, w_qb):
    q = jnp.matmul(rmsnorm(cq, q_norm_g), w_qb).reshape(cq.shape[:2] + (MLA_HEADS, QK_NOPE + QK_ROPE))
    return jnp.split(q, [QK_NOPE], axis=-1)


def mla_kv(ckv, kv_norm_g, w_kvb):
    kv = jnp.matmul(rmsnorm(ckv, kv_norm_g), w_kvb).reshape(ckv.shape[:2] + (MLA_HEADS, QK_NOPE + V_HEAD))
    return jnp.split(kv, [QK_NOPE], axis=-1)


def attend(q_nope, q_rope, k_nope, k_rope, v):
    s = (jnp.einsum('bqhd,bkhd->bhqk', q_nope, k_nope, preferred_element_type=jnp.float32)
         + jnp.einsum('bqhr,bkr->bhqk', q_rope, k_rope, preferred_element_type=jnp.float32)) * SM_SCALE
    p = jax.nn.softmax(s, axis=-1).astype(v.dtype)
    return jnp.einsum('bhqk,bkhd->bqhd', p, v)


def blocked_attend(q_nope, q_rope, k_nope, k_rope, v):
    b_, l_ = q_nope.shape[:2]
    nb = l_ // Q_BLOCK
    qn = q_nope.reshape(b_, nb, Q_BLOCK, MLA_HEADS, QK_NOPE).swapaxes(0, 1)
    qr = q_rope.reshape(b_, nb, Q_BLOCK, MLA_HEADS, QK_ROPE).swapaxes(0, 1)
    out = lax.map(lambda qs: attend(qs[0], qs[1], k_nope, k_rope, v), (qn, qr))
    return out.swapaxes(0, 1).reshape(b_, l_, MLA_HEADS * V_HEAD)


def chunk_sgu(zu, zv, ln_g, ln_b, sgu_w, sgu_b):
    b_, l_, _ = zu.shape
    v = layernorm(zv, ln_g, ln_b).reshape(b_, l_ // CHUNK, CHUNK, SGU_HEADS, SGU_HEAD_DIM)
    mixed = jnp.einsum('hij,bnjhd->bnihd', sgu_w, v) + sgu_b.T[None, None, :, :, None]
    return zu * mixed.reshape(b_, l_, D_SGU)


def mla_sgu_mixer(h, hc, w_in, q_norm_g, w_qb, kv_norm_g, w_kvb, sgu_ln_g, sgu_ln_b, sgu_w, sgu_b,
                  w_out, cos, sin, with_ctx_out):
    cols = (COL_Q, COL_KV, COL_KR, COL_U)
    cq, ckv, kr, zu, zv = jnp.split(jnp.matmul(h, w_in), cols, axis=-1)
    if with_ctx_out:
        cq_c, ckv_c, kr_c, zu_c, zv_c = jnp.split(jnp.matmul(hc, w_in), cols, axis=-1)
    else:
        ckv_c, kr_c = jnp.split(jnp.matmul(hc, w_in[:, COL_Q:COL_KR]), [KV_LORA], axis=-1)
    kn_c, v_c = mla_kv(ckv_c, kv_norm_g, w_kvb)
    kn, v = mla_kv(ckv, kv_norm_g, w_kvb)
    kr = apply_rope_2d(kr, cos, sin)
    qn, qr = mla_q(cq, q_norm_g, w_qb)
    qr = apply_rope_2d(qr, cos[:, None], sin[:, None])
    k_nope = jnp.concatenate([kn_c, kn], axis=1)
    k_rope = jnp.concatenate([kr_c, kr], axis=1)
    v_all = jnp.concatenate([v_c, v], axis=1)
    attn = blocked_attend(qn, qr, k_nope, k_rope, v_all)
    sg = chunk_sgu(jax.nn.gelu(zu), jax.nn.gelu(zv), sgu_ln_g, sgu_ln_b, sgu_w, sgu_b)
    out = jnp.matmul(jnp.concatenate([attn, sg], axis=-1), w_out)
    out_c = None
    if with_ctx_out:
        qn_c, qr_c = mla_q(cq_c, q_norm_g, w_qb)
        attn_c = attend(qn_c, qr_c, kn_c, kr_c, v_c).reshape(hc.shape[:2] + (MLA_HEADS * V_HEAD,))
        sg_c = chunk_sgu(jax.nn.gelu(zu_c), jax.nn.gelu(zv_c), sgu_ln_g, sgu_ln_b, sgu_w, sgu_b)
        out_c = jnp.matmul(jnp.concatenate([attn_c, sg_c], axis=-1), w_out)
    return out, out_c


def setup_inputs(seed: int = 0) -> dict:
    key = jax.random.key(seed)
    ks = iter(jax.random.split(key, 48))
    D = D_MODEL

    def nrm(shape, scale=1.0):
        return jax.random.normal(next(ks), shape, jnp.float32) * scale

    def gain(shape):
        return 1.0 + 0.02 * jax.random.normal(next(ks), shape, jnp.float32)

    return {
        "x": nrm((BATCH, SEQ, D)),
        "c": nrm((BATCH, D)),
        "ctx": nrm((BATCH, CTX_LEN, D)),
        "c_ctx": nrm((D,)),
        "ada_w": nrm((DEPTH, D, N_MOD * D), 0.5 * D ** -0.5),
        "ada_b": nrm((DEPTH, N_MOD * D), 0.02),
        "norm1_g": gain((DEPTH, D)),
        "norm2_g": gain((DEPTH, D)),
        "e_w_in": nrm((N_EVEN, D, D_IN_EVEN), D ** -0.5),
        "e_pool_w": nrm((N_EVEN, POOL_GROUPS, POOL_GROUP_DIM, POOL_GROUP_DIM), POOL_GROUP_DIM ** -0.5),
        "e_pool_scale": gain((N_EVEN, D_POOL)),
        "e_conv_w": nrm((N_EVEN, CONV_WIDTH, D_CONV), CONV_WIDTH ** -0.5),
        "e_conv_b": nrm((N_EVEN, D_CONV), 0.02),
        "e_conv_ln_g": gain((N_EVEN, D_CONV)),
        "e_conv_ln_b": nrm((N_EVEN, D_CONV), 0.02),
        "e_w_out": nrm((N_EVEN, D_MIX_EVEN, D), D_MIX_EVEN ** -0.5),
        "e_ffn_w_gate": nrm((N_EVEN, D, D_FF), D ** -0.5),
        "e_ffn_w_up": nrm((N_EVEN, D, D_FF), D ** -0.5),
        "e_ffn_w_down": nrm((N_EVEN, D_FF, D), D_FF ** -0.5),
        "o_w_in": nrm((N_ODD, D, D_IN_ODD), D ** -0.5),
        "o_q_norm_g": gain((N_ODD, Q_LORA)),
        "o_w_qb": nrm((N_ODD, Q_LORA, MLA_HEADS * (QK_NOPE + QK_ROPE)), Q_LORA ** -0.5),
        "o_kv_norm_g": gain((N_ODD, KV_LORA)),
        "o_w_kvb": nrm((N_ODD, KV_LORA, MLA_HEADS * (QK_NOPE + V_HEAD)), KV_LORA ** -0.5),
        "o_sgu_ln_g": gain((N_ODD, D_SGU)),
        "o_sgu_ln_b": nrm((N_ODD, D_SGU), 0.02),
        "o_sgu_w": nrm((N_ODD, SGU_HEADS, CHUNK, CHUNK), CHUNK ** -0.5),
        "o_sgu_b": gain((N_ODD, SGU_HEADS, CHUNK)),
        "o_w_out": nrm((N_ODD, D_MIX_ODD, D), D_MIX_ODD ** -0.5),
        "o_router_w": nrm((N_ODD, D, N_EXPERTS), D ** -0.5),
        "o_router_b": nrm((N_ODD, N_EXPERTS), 0.01),
        "o_exp_w_gate": nrm((N_ODD, N_EXPERTS, D, D_FF_EXPERT), D ** -0.5),
        "o_exp_w_up": nrm((N_ODD, N_EXPERTS, D, D_FF_EXPERT), D ** -0.5),
        "o_exp_w_down": nrm((N_ODD, N_EXPERTS, D_FF_EXPERT, D), D_FF_EXPERT ** -0.5),
        "final_norm_g": gain((D,)),
    }


def reference(x, c, ctx, c_ctx, ada_w, ada_b, norm1_g, norm2_g,
              e_w_in, e_pool_w, e_pool_scale, e_conv_w, e_conv_b, e_conv_ln_g, e_conv_ln_b, e_w_out,
              e_ffn_w_gate, e_ffn_w_up, e_ffn_w_down,
              o_w_in, o_q_norm_g, o_w_qb, o_kv_norm_g, o_w_kvb, o_sgu_ln_g, o_sgu_ln_b, o_sgu_w, o_sgu_b,
              o_w_out, o_router_w, o_router_b, o_exp_w_gate, o_exp_w_up, o_exp_w_down, final_norm_g):
    seq_len = x.shape[1]
    cos, sin = rope_tables(seq_len)
    for i in range(DEPTH):
        j = i // 2
        even = i % 2 == 0
        last = i == DEPTH - 1
        need_ctx = (not last) or (not even)
        sh1, sc1, g1, sh2, sc2, g2 = ada_params(c, ada_w[i], ada_b[i])
        h = modulate(rmsnorm(x, norm1_g[i]), sh1, sc1)
        if need_ctx:
            csh1, csc1, cg1, csh2, csc2, cg2 = ada_params(c_ctx, ada_w[i], ada_b[i])
            hc = modulate(rmsnorm(ctx, norm1_g[i]), csh1, csc1)
        if even:
            mix = functools.partial(pool_conv_mixer, w_in=e_w_in[j], pool_w=e_pool_w[j],
                                    pool_scale=e_pool_scale[j], conv_w=e_conv_w[j], conv_b=e_conv_b[j],
                                    ln_g=e_conv_ln_g[j], ln_b=e_conv_ln_b[j], w_out=e_w_out[j])
            out = mix(h)
            out_c = None if last else mix(hc)
            ffn = functools.partial(swiglu, w_gate=e_ffn_w_gate[j], w_up=e_ffn_w_up[j],
                                    w_down=e_ffn_w_down[j])
        else:
            out, out_c = mla_sgu_mixer(h, hc, o_w_in[j], o_q_norm_g[j], o_w_qb[j], o_kv_norm_g[j],
                                       o_w_kvb[j], o_sgu_ln_g[j], o_sgu_ln_b[j], o_sgu_w[j], o_sgu_b[j],
                                       o_w_out[j], cos, sin, not last)
            ffn = functools.partial(moe_swiglu, router_w=o_router_w[j], router_b=o_router_b[j],
                                    w_gate=o_exp_w_gate[j], w_up=o_exp_w_up[j], w_down=o_exp_w_down[j])
        x = x + g1 * out
        x = x + g2 * ffn(modulate(rmsnorm(x, norm2_g[i]), sh2, sc2))
        if not last:
            ctx = ctx + cg1 * out_c
            ctx = ctx + cg2 * ffn(modulate(rmsnorm(ctx, norm2_g[i]), csh2, csc2))
    return rmsnorm(x, final_norm_g)
```

```cpp
#include <hip/hip_runtime.h>
#include <cstdio>
#include <cstdint>
#include <cstring>
#include <cstddef>

#define LAS __attribute__((address_space(3)))
typedef unsigned short bf16_t;
typedef short bf16x8 __attribute__((ext_vector_type(8)));
typedef short s16x4 __attribute__((ext_vector_type(4)));
typedef float f32x2 __attribute__((ext_vector_type(2)));
typedef float f32x4 __attribute__((ext_vector_type(4)));
typedef float f32x16 __attribute__((ext_vector_type(16)));
typedef unsigned u32x2 __attribute__((ext_vector_type(2)));
typedef unsigned u32x4 __attribute__((ext_vector_type(4)));

constexpr int DM = 2048, NB = 4, SEQ = 4096, CTXL = 256;
constexpr int ML = NB * SEQ;
constexpr int MC = NB * CTXL;
constexpr int MT = ML + MC;
constexpr int DFF = 5632, DFFE = 7168, NEXP = 8;
constexpr int KVL = CTXL + SEQ;
constexpr int NMOD = 6 * DM;
constexpr float EPS = 1e-6f;
constexpr int MOE_ROWS = 2 * ML + NEXP * 256;
constexpr float W1S = 64.0f, W2S = 128.0f, ACTS = 4.0f;
constexpr float Q8S = 1.0f;
constexpr float QSCALE = 0.07216878364870322f * 1.4426950408889634f;

constexpr size_t al256(size_t x) { return (x + 255) & ~(size_t)255; }
constexpr size_t WS_CTL = 0, CTL_BYTES = 1u << 20;
constexpr int CW_BAR = 0;
constexpr int CW_ECNT = 4096;
constexpr int CW_TILE = 8192;
constexpr int CW_PHDONE = 8256;
constexpr int CW_SSQQ = 16384;
constexpr int CW_SSQKV = 32768;
constexpr int CW_ZS1 = 65536;
constexpr int CW_ZS2 = 81920;
constexpr int CW_CMAX_EIN = 109568;
constexpr int CW_CMAX_OIN = 112640;
constexpr int CW_CMAX = 98304;
constexpr size_t WS_MOD = 1u << 20;
constexpr size_t WS_ROPE = WS_MOD + (512u << 10);
constexpr size_t WS_TOK = 2u << 20;
constexpr size_t WS_LIST = WS_TOK + (512u << 10);
constexpr size_t WS_RSC = 3u << 20;
constexpr size_t WS_W0 = 4u << 20;
constexpr size_t WS_WEIN = WS_W0;
constexpr size_t WS_WEOUT = WS_WEIN + (size_t)3072 * 2048 * 2;
constexpr size_t WS_WF1 = WS_WEOUT + (size_t)2048 * 2048 * 2;
constexpr size_t WS_WF2 = WS_WF1 + (size_t)11264 * 2048 * 2;
constexpr size_t WS_WOIN = WS_WF2 + (size_t)2048 * 5632 * 2;
constexpr size_t WS_WQB = WS_WOIN + (size_t)3328 * 2048 * 2;
constexpr size_t WS_WKVB = WS_WQB + (size_t)1536 * 512 * 2;
constexpr size_t WS_WSGU = WS_WKVB + (size_t)2048 * 512 * 2;
constexpr size_t WS_WOOUT = WS_WSGU + (size_t)8 * 128 * 128 * 2;
constexpr size_t WS_WM1 = WS_WOOUT + (size_t)2048 * 2048 * 2;
constexpr size_t WS_WM2 = WS_WM1 + (size_t)8 * 14336 * 2048;
constexpr size_t WS_XA = al256(WS_WM2 + (size_t)8 * 2048 * 7168);
constexpr size_t WS_HN = WS_XA + (size_t)MT * DM * 4;
constexpr size_t WS_Y0 = WS_HN + (size_t)MT * DM * 2;
constexpr size_t WS_YB = WS_HN;
constexpr size_t WS_AR = WS_Y0 + (size_t)MT * DM * 2;
constexpr size_t AR_BYTES = (size_t)MOE_ROWS * DFFE * 2;
constexpr size_t WS_ACT0 = WS_AR;
constexpr size_t WS_U = WS_ACT0 + (size_t)MT * DFF * 2;
constexpr size_t WS_Z = WS_U + (size_t)MT * 1024 * 2;
constexpr size_t WS_CQ = WS_AR;
constexpr size_t WS_CKV = WS_CQ + (size_t)ML * 512 * 2;
constexpr size_t WS_GU = WS_CKV + (size_t)MT * 512 * 2;
constexpr size_t WS_GV = WS_GU + (size_t)ML * 1024 * 2;
constexpr size_t WS_Q = WS_GV + (size_t)ML * 1024 * 2;
constexpr size_t WS_K = WS_Q + (size_t)ML * 1536 * 2;
constexpr size_t WS_V = WS_K + (size_t)MT * 1536 * 2;
constexpr size_t WS_L1END = WS_V + (size_t)MT * 1024 * 2;
constexpr size_t WS_ACT1 = WS_AR;
constexpr size_t WS_HNP = WS_AR + AR_BYTES;
constexpr size_t WS_PART = WS_HNP + (size_t)NEXP * ML * DM;
constexpr size_t WS_MCM = WS_PART + (size_t)4 * MC * DM * 4;
constexpr size_t WS_MRS = WS_MCM + (size_t)NEXP * 14336 * 4;
constexpr size_t WS_END = WS_MRS + (size_t)NEXP * ML * 4;
constexpr int CW_MOEMAX = 120000;
static_assert(WS_Z + (size_t)MT * 1024 * 2 <= WS_END && WS_L1END <= WS_END, "arena");
static_assert((size_t)MOE_ROWS * DM * 2 == 2 * (size_t)MT * DM * 2, "YB overlays HN|Y0");

constexpr int LDS_BYTES = 147456;
constexpr int LDS_MISC = 131072;

__device__ __forceinline__ unsigned cvt_pk_bf16(float lo, float hi) { unsigned r; asm("v_cvt_pk_bf16_f32 %0, %1, %2" : "=v"(r) : "v"(lo), "v"(hi)); return r; }
__device__ __forceinline__ float clamp448(float x) { return __builtin_amdgcn_fmed3f(x, -448.0f, 448.0f); }
__device__ __forceinline__ unsigned cvt4_fp8(float a, float b, float c, float d) { int w = 0; w = __builtin_amdgcn_cvt_pk_fp8_f32(clamp448(a), clamp448(b), w, false); w = __builtin_amdgcn_cvt_pk_fp8_f32(clamp448(c), clamp448(d), w, true); return (unsigned)w; }
__device__ __forceinline__ unsigned cvt4_i8(float a, float b, float c, float d) {
    constexpr float M = 12582912.0f;
    const unsigned ua = __float_as_uint(__builtin_amdgcn_fmed3f(a + M, M - 127.f, M + 127.f)), ub = __float_as_uint(__builtin_amdgcn_fmed3f(b + M, M - 127.f, M + 127.f));
    const unsigned uc = __float_as_uint(__builtin_amdgcn_fmed3f(c + M, M - 127.f, M + 127.f)), ud = __float_as_uint(__builtin_amdgcn_fmed3f(d + M, M - 127.f, M + 127.f));
    const unsigned t01 = __builtin_amdgcn_perm(ub, ua, 0x0c0c0400u), t23 = __builtin_amdgcn_perm(ud, uc, 0x0c0c0400u);
    return __builtin_amdgcn_perm(t23, t01, 0x05040100u); }
__device__ __forceinline__ float bf_lo(unsigned w) { return __uint_as_float(w << 16); }
__device__ __forceinline__ float bf_hi(unsigned w) { return __uint_as_float(w & 0xffff0000u); }
__device__ __forceinline__ f32x4 ld4_bf(const bf16_t* p) { const u32x2 w = *(const u32x2*)p; return (f32x4){bf_lo(w.x), bf_hi(w.x), bf_lo(w.y), bf_hi(w.y)}; }
__device__ __forceinline__ void st4_bf(bf16_t* p, const f32x4 v) { u32x2 w; w.x = cvt_pk_bf16(v[0], v[1]); w.y = cvt_pk_bf16(v[2], v[3]); *(u32x2*)p = w; }
__device__ __forceinline__ float wave_sum(float v) {
#pragma unroll
    for (int o = 1; o < 64; o <<= 1) v += __shfl_xor(v, o);
    return v;
}
__device__ __forceinline__ int tid_opaque() { int t = threadIdx.x; asm volatile("" : "+v"(t)); return t; }
__device__ __forceinline__ float sum4(const f32x4 v) { return (v[0] + v[1]) + (v[2] + v[3]); }
__device__ __forceinline__ float sq4(const f32x4 v) { return (v[0] * v[0] + v[1] * v[1]) + (v[2] * v[2] + v[3] * v[3]); }
__device__ __forceinline__ float sigmoidf_(float x) { return __builtin_amdgcn_rcpf(1.0f + __expf(-x)); }
__device__ __forceinline__ float siluf_(float x) { return x * sigmoidf_(x); }
__device__ __forceinline__ float gelu_tanh(float x) { const float u = 0.7978845608028654f * (x + 0.044715f * x * x * x); return x * sigmoidf_(2.0f * u); }
__device__ __forceinline__ int v_pos(int kk) { return (((kk >> 2) & 1) << 5) + ((kk >> 5) << 4) + (kk & 3) + 4 * ((kk >> 3) & 3); }
__device__ __forceinline__ int krow_of(int r) { return r < ML ? (r >> 12) * KVL + CTXL + (r & 4095) : ((r - ML) >> 8) * KVL + ((r - ML) & 255); }
__device__ __forceinline__ int cond_of(int r) { return r < ML ? (r >> 12) : 4; }

#define XB_TMO      128
#define XB_XCNT(j)  (256  + 64 * (j))
#define XB_XSUB(j)  (1280 + 64 * (j))
#define XB_XGEN(j)  (2304 + 64 * (j))
#define XB_TOP      3328
#define XB_TOPGEN   3392
#define XCD_BAR_WORDS 3456
#define XB_SPIN_CAP (1u << 18)
__device__ __forceinline__ unsigned xb_ld(unsigned* p)              { return __hip_atomic_load(p, __ATOMIC_RELAXED, __HIP_MEMORY_SCOPE_AGENT); }
__device__ __forceinline__ unsigned xb_add(unsigned* p, unsigned v) { return __hip_atomic_fetch_add(p, v, __ATOMIC_RELAXED, __HIP_MEMORY_SCOPE_AGENT); }
__device__ __forceinline__ unsigned xb_xcc_id() { return (unsigned)__builtin_amdgcn_s_getreg((3 << 11) | 20) & 0xFu; }
#define XB_SPIN(cond, bar) do { unsigned _sp = 0; while (cond) { __builtin_amdgcn_s_sleep(1); \
    if ((++_sp & 255u) == 0u) { if (xb_ld(&(bar)[XB_TMO])) break; if (_sp > XB_SPIN_CAP) { atomicAdd(&(bar)[XB_TMO], 1u); break; } } } } while (0)
struct XcdBarrier { unsigned* bar; unsigned x; volatile LAS unsigned* st; unsigned G; };
__device__ __forceinline__ XcdBarrier xcd_barrier_post(unsigned* bar, volatile LAS unsigned* st) {
    XcdBarrier b; b.bar = bar; b.x = xb_xcc_id(); b.st = st; b.G = gridDim.x;
    if (threadIdx.x == 0) (void)xb_add(&bar[XB_XCNT(b.x)], 1u);
    return b;
}
__device__ __forceinline__ void xcd_barrier_complete(unsigned* bar, unsigned x, unsigned G, unsigned& nloc, unsigned& nx) {
    unsigned sum, cnt, mine, sp = 0u;
    for (;;) {
        sum = 0u; cnt = 0u; mine = 0u;
#pragma unroll
        for (unsigned j = 0; j < 16; ++j) { const unsigned c = xb_ld(&bar[XB_XCNT(j)]); sum += c; cnt += (c > 0u) ? 1u : 0u; mine = (j == x) ? c : mine; }
        if (sum == G) break;
        __builtin_amdgcn_s_sleep(1);
        if ((++sp & 255u) == 0u) { if (xb_ld(&bar[XB_TMO])) break; if (sp > XB_SPIN_CAP) { atomicAdd(&bar[XB_TMO], 1u); break; } }
    }
    nloc = mine > 0u ? mine : 1u; nx = cnt > 0u ? cnt : 1u;
}
__device__ __forceinline__ void xcd_barrier(const XcdBarrier& b) {
    asm volatile("s_waitcnt vmcnt(0)" ::: "memory");
    __syncthreads();
    int t_ = threadIdx.x; asm volatile("" : "+v"(t_));
    if (t_ == 0) {
        unsigned* bar = b.bar;
        __builtin_amdgcn_s_waitcnt(0);
        unsigned nloc = b.st[0], nx = b.st[1];
        if (nloc == 0u) { xcd_barrier_complete(bar, b.x, b.G, nloc, nx); b.st[0] = nloc; b.st[1] = nx; }
        const unsigned old = xb_add(&bar[XB_XSUB(b.x)], 1u);
        const unsigned gen = old / nloc;
        if (old + 1u == (gen + 1u) * nloc) {
            __builtin_amdgcn_fence(__ATOMIC_RELEASE, "agent");
            asm volatile("s_waitcnt vmcnt(0)" ::: "memory");
            const unsigned og = xb_add(&bar[XB_TOP], 1u);
            const unsigned tg = og / nx;
            if (og + 1u == (tg + 1u) * nx) xb_add(&bar[XB_TOPGEN], 1u);
            else XB_SPIN(xb_ld(&bar[XB_TOPGEN]) == tg, bar);
            __builtin_amdgcn_fence(__ATOMIC_ACQUIRE, "agent");
            xb_add(&bar[XB_XGEN(b.x)], 1u);
            asm volatile("s_waitcnt vmcnt(0)" ::: "memory");
        } else {
            XB_SPIN(xb_ld(&bar[XB_XGEN(b.x)]) == gen, bar);
            __builtin_amdgcn_fence(__ATOMIC_ACQUIRE, "agent");
            asm volatile("s_waitcnt vmcnt(0)" ::: "memory");
        }
    }
    __syncthreads();
}

namespace pg8 {
constexpr int BM = 256, BK = 64, HALF = 128, HTB = HALF * BK * 2, STAGE_BYTES = 8 * HTB, NXCD = 8, WGM = 8;
__device__ __forceinline__ int lds_byte(int r, int c) { const int st = (r >> 4) * 2 + (c >> 5), rr = r & 15, cc = c & 31, ob = rr * 64 + cc * 2; return st * 1024 + (ob ^ (((ob >> 9) & 1) << 5)); }
__device__ __forceinline__ void stage_rc(int b, int& R, int& C) { const int st = b / 1024, sb = b % 1024, swz = sb ^ (((sb >> 9) & 1) << 5); R = (st >> 1) * 16 + swz / 64; C = (st & 1) * 32 + (swz % 64) / 2; }
__device__ __forceinline__ int perm32(int rho) { const int n = rho >> 4, i = rho & 15; return 8 * (i >> 2) + 4 * n + (i & 3); }

struct Unit { int pm, pn, g, orow0, kt0, nt; };

__device__ __forceinline__ void tile_map(int id, int nM, int nN, int& pm, int& pn) {
    const int nwg = nM * nN;
    int wgid = id; { const int q = nwg / NXCD, r = nwg % NXCD, xcd = wgid % NXCD, off = wgid / NXCD; wgid = (xcd < r ? xcd * (q + 1) : r * (q + 1) + (xcd - r) * q) + off; }
    const int nig = WGM * nN, gid = wgid / nig, fm = gid * WGM, gsz = (nM - fm) < WGM ? (nM - fm) : WGM;
    pm = fm + ((wgid % nig) % gsz); pn = (wgid % nig) / gsz;
}

struct DenseSched {
    const char* Bt; int lda, ldb, G, c; int nM0, nN0, nM1, nN1, pm1, pn1; int ntK, ksplit;
    __device__ __forceinline__ bool next(int i, Unit& u) const {
        const int L = i * G + c; const int n0 = nM0 * nN0;
        if (L < n0) { tile_map(L, nM0, nN0, u.pm, u.pn); u.g = -1; u.kt0 = 0; u.nt = ntK; }
        else { const int l2 = L - n0; if (l2 >= nM1 * nN1 * ksplit) return false; int a, b; const int part = l2 % ksplit; tile_map(l2 / ksplit, nM1, nN1, a, b); u.pm = pm1 + a; u.pn = pn1 + b;
            if (ksplit > 1) { u.g = part; u.nt = ntK / ksplit; u.kt0 = part * u.nt; } else { u.g = -1; u.kt0 = 0; u.nt = ntK; } }
        u.orow0 = u.pm * BM; return true;
    }
    __device__ __forceinline__ const char* Bptr(const Unit& u) const { return Bt + (size_t)u.pn * BM * ldb * 2 + (size_t)u.kt0 * (BK * 2); }
    __device__ __forceinline__ unsigned Aoff(const Unit& u, int rloc) const { return (unsigned)(u.pm * BM + rloc) * (unsigned)lda * 2u + (unsigned)u.kt0 * (BK * 2); }
};
struct QKVSched {
    const char* Bq; const char* Bkv; unsigned aoff1; int lda, ldb, G, c;
    __device__ __forceinline__ bool next(int i, Unit& u) const {
        const int L = i * G + c; constexpr int n0 = (ML / 256) * 6, n1 = (MT / 256) * 8;
        if (L < n0) { tile_map(L, ML / 256, 6, u.pm, u.pn); u.g = 0; } else { if (L - n0 >= n1) return false; tile_map(L - n0, MT / 256, 8, u.pm, u.pn); u.g = 1; }
        u.orow0 = u.pm * BM; u.kt0 = 0; u.nt = 8; return true;
    }
    __device__ __forceinline__ const char* Bptr(const Unit& u) const { return (u.g ? Bkv : Bq) + (size_t)u.pn * BM * ldb * 2; }
    __device__ __forceinline__ unsigned Aoff(const Unit& u, int rloc) const { return (u.g ? aoff1 : 0u) + (unsigned)(u.pm * BM + rloc) * (unsigned)lda * 2u; }
};
struct MoeSched {
    const char* Bt; const int* list; volatile LAS int* tab; int lda, ldb, G, c, nN, gather; size_t bstride; int ntK;
    __device__ __forceinline__ bool next(int i, Unit& u) const {
        const int L = i * G + c; if (L >= tab[24]) return false;
        int e = 0;
#pragma unroll
        for (int j = 1; j < 8; ++j) e += (L >= tab[16 + j]) ? 1 : 0;
        const int cnt = tab[e], np = (cnt + 255) >> 8;
        tile_map(L - tab[16 + e], np, nN, u.pm, u.pn); u.g = e; u.orow0 = (tab[8 + e] + u.pm) * BM; u.kt0 = 0; u.nt = ntK; return true;
    }
    __device__ __forceinline__ const char* Bptr(const Unit& u) const { return Bt + (size_t)u.g * bstride + (size_t)u.pn * BM * ldb * 2; }
    __device__ __forceinline__ unsigned Aoff(const Unit& u, int rloc) const {
        if (gather) return (unsigned)(u.g * ML + u.pm * BM + rloc) * (unsigned)lda * 2u;
        return (unsigned)(u.orow0 + rloc) * (unsigned)lda * 2u;
    }
};

typedef int i32x8 __attribute__((ext_vector_type(8)));
typedef int i32x4v __attribute__((ext_vector_type(4)));
template <class Epi, class Sched, int FP8 = 0>
__device__ __forceinline__ void gemm_phase(LAS unsigned char* lds, const char* Abase, const int K, const Sched& S, const Epi& E) {
    const int tid = threadIdx.x, wid = __builtin_amdgcn_readfirstlane(tid >> 6), lane = tid & 63, wr = wid >> 2, wc = wid & 3, fr = lane & 15, fq = lane >> 4;
    (void)K;
    int Rr[2], Cc[2]; unsigned voffB[2];
#pragma unroll
    for (int i = 0; i < 2; ++i) { stage_rc(tid * 16 + i * 8192, Rr[i], Cc[i]); const int Rb = Epi::PERM ? ((Rr[i] & ~31) + perm32(Rr[i] & 31)) : Rr[i];
        voffB[i] = (unsigned)(Rb * S.ldb + Cc[i]) * 2u; }
    const size_t kstep = (size_t)(BK * 2);
    const size_t hstepB = (size_t)HALF * S.ldb * 2;
    const unsigned ldsw = (unsigned)wid * 1024u;
    const int aoff = lds_byte(wr * 64 + fr, fq * 8), boff = lds_byte(wc * 32 + fr, fq * 8);
#define PG8_SA(b, h) (((b) * 2 + (h)) * HTB)
#define PG8_SB(b, h) ((4 + (b) * 2 + (h)) * HTB)
#define PG8_STAGE(bufoff, gbase, voff) do { _Pragma("unroll") for (int _i = 0; _i < 2; ++_i) { unsigned vo_ = (voff)[_i]; asm volatile("" : "+v"(vo_));   \
        __builtin_amdgcn_global_load_lds((const unsigned*)((const char*)(gbase) + vo_), (LAS unsigned*)(lds + (bufoff) + ldsw + _i * 8192), 16, 0, 0); } } while (0)
#define PG8_LDA(dst, b, h) do { _Pragma("unroll") for (int m = 0; m < 4; ++m) _Pragma("unroll") for (int k = 0; k < 2; ++k) dst[m][k] = *(const LAS bf16x8*)(lds + PG8_SA(b, h) + aoff + m * 2048 + k * 1024); } while (0)
#define PG8_LDB(dst, b, h) do { _Pragma("unroll") for (int n = 0; n < 2; ++n) _Pragma("unroll") for (int k = 0; k < 2; ++k) dst[n][k] = *(const LAS bf16x8*)(lds + PG8_SB(b, h) + boff + n * 2048 + k * 1024); } while (0)
#define PG8_CAT8(x) (i32x8){((const int*)&(x)[0])[0], ((const int*)&(x)[0])[1], ((const int*)&(x)[0])[2], ((const int*)&(x)[0])[3], ((const int*)&(x)[1])[0], ((const int*)&(x)[1])[1], ((const int*)&(x)[1])[2], ((const int*)&(x)[1])[3]}
#define PG8_MMA(ai, bj, At, Bt) do { __builtin_amdgcn_s_setprio(1); _Pragma("unroll") for (int m = 0; m < 4; ++m) _Pragma("unroll") for (int n = 0; n < 2; ++n) { \
        if constexpr (FP8 == 1) acc[ai][bj][m][n] = __builtin_amdgcn_mfma_scale_f32_16x16x128_f8f6f4(PG8_CAT8(Bt[n]), PG8_CAT8(At[m]), acc[ai][bj][m][n], 0, 0, 0, 127, 0, 127); \
        else if constexpr (FP8 == 2) { _Pragma("unroll") for (int k = 0; k < 2; ++k) acc[ai][bj][m][n] = __builtin_bit_cast(f32x4, __builtin_amdgcn_mfma_i32_16x16x64_i8(__builtin_bit_cast(i32x4v, Bt[n][k]), __builtin_bit_cast(i32x4v, At[m][k]), __builtin_bit_cast(i32x4v, acc[ai][bj][m][n]), 0, 0, 0)); } \
        else { _Pragma("unroll") for (int k = 0; k < 2; ++k) acc[ai][bj][m][n] = __builtin_amdgcn_mfma_f32_16x16x32_bf16(Bt[n][k], At[m][k], acc[ai][bj][m][n], 0, 0, 0); } } \
        __builtin_amdgcn_s_setprio(0); } while (0)
#define PG8_WAIT_V(n) asm volatile("s_waitcnt vmcnt(" #n ")" ::: "memory")
#define PG8_WAIT_L(n) asm volatile("s_waitcnt lgkmcnt(" #n ")" ::: "memory")
#define PG8_BAR __builtin_amdgcn_s_barrier()
#define PG8_SCHED __builtin_amdgcn_sched_barrier(0)
#define PG8_AOFFS(dst, un) do { _Pragma("unroll") for (int _h = 0; _h < 2; ++_h) _Pragma("unroll") for (int _i = 0; _i < 2; ++_i) dst[_h][_i] = S.Aoff(un, _h * HALF + Rr[_i]) + (unsigned)Cc[_i] * 2u; } while (0)
    Unit cur, nxt; int ui = 0;
    if (!S.next(0, cur)) return;
    f32x4 acc[2][2][4][2];
#pragma unroll
    for (int a = 0; a < 2; ++a)
#pragma unroll
        for (int b = 0; b < 2; ++b)
#pragma unroll
            for (int m = 0; m < 4; ++m)
#pragma unroll
                for (int n = 0; n < 2; ++n) acc[a][b][m][n] = (f32x4){0.f, 0.f, 0.f, 0.f};
    bf16x8 At[4][2], B0[2][2], B1[2][2];
    unsigned va[2][2];
    PG8_AOFFS(va, cur);
    const char* cB = S.Bptr(cur);
    PG8_STAGE(PG8_SB(0, 0), cB, voffB); PG8_STAGE(PG8_SB(0, 1), cB + hstepB, voffB); PG8_STAGE(PG8_SA(0, 0), Abase, va[0]); PG8_STAGE(PG8_SA(0, 1), Abase, va[1]);
    if (wr == 1) PG8_BAR;
    PG8_WAIT_V(2); PG8_BAR;
    PG8_STAGE(PG8_SB(1, 0), cB + kstep, voffB); PG8_STAGE(PG8_SA(1, 0), Abase + kstep, va[0]); PG8_STAGE(PG8_SB(1, 1), cB + hstepB + kstep, voffB);
    PG8_WAIT_V(6); PG8_BAR;
    for (;;) {
        const bool has_next = S.next(ui + 1, nxt);
        const char* nB = has_next ? S.Bptr(nxt) : cB;
        const int nt = cur.nt;
        for (int t = 0; t < nt; t += 2) {
            const bool last = (t == nt - 2);
            const char* a1 = Abase + (size_t)(t + 1) * kstep;
            const char* a2 = Abase + (last ? (size_t)0 : (size_t)(t + 2) * kstep); const char* b2 = last ? nB : cB + (size_t)(t + 2) * kstep;
            const char* a3 = a2 + kstep; const char* b3 = b2 + kstep;
            PG8_LDB(B0, 0, 0); PG8_LDB(B1, 0, 1); PG8_SCHED; PG8_LDA(At, 0, 0); PG8_STAGE(PG8_SA(1, 1), a1, va[1]);
            PG8_WAIT_V(8); PG8_WAIT_L(0); PG8_BAR; PG8_MMA(0, 0, At, B0); PG8_MMA(0, 1, At, B1); PG8_BAR; PG8_SCHED;
            if (last && has_next) { PG8_AOFFS(va, nxt); }
            PG8_LDA(At, 0, 1); PG8_STAGE(PG8_SB(0, 0), b2, voffB); PG8_STAGE(PG8_SB(0, 1), b2 + hstepB, voffB); PG8_STAGE(PG8_SA(0, 0), a2, va[0]);
            PG8_WAIT_V(8); PG8_WAIT_L(0); PG8_BAR; PG8_MMA(1, 0, At, B0); PG8_MMA(1, 1, At, B1); PG8_BAR; PG8_SCHED;
            PG8_LDB(B0, 1, 0); PG8_LDB(B1, 1, 1); PG8_SCHED; PG8_LDA(At, 1, 0); PG8_STAGE(PG8_SA(0, 1), a2, va[1]);
            PG8_WAIT_V(8); PG8_WAIT_L(0); PG8_BAR; PG8_MMA(0, 0, At, B0); PG8_MMA(0, 1, At, B1); PG8_BAR; PG8_SCHED;
            PG8_LDA(At, 1, 1); PG8_STAGE(PG8_SB(1, 0), b3, voffB); PG8_STAGE(PG8_SB(1, 1), b3 + hstepB, voffB); PG8_STAGE(PG8_SA(1, 0), a3, va[0]);
            PG8_WAIT_V(8); PG8_WAIT_L(0); PG8_BAR; PG8_MMA(1, 0, At, B0); PG8_MMA(1, 1, At, B1); PG8_BAR; PG8_SCHED;
        }
        if (wr == 0) PG8_BAR;
        E(acc, cur, wr, wc, fr, fq);
        if (!has_next) break;
#pragma unroll
        for (int a = 0; a < 2; ++a)
#pragma unroll
            for (int b = 0; b < 2; ++b)
#pragma unroll
                for (int m = 0; m < 4; ++m)
#pragma unroll
                    for (int n = 0; n < 2; ++n) acc[a][b][m][n] = (f32x4){0.f, 0.f, 0.f, 0.f};
        cur = nxt; cB = nB; ++ui;
        if (wr == 1) PG8_BAR;
    }
    PG8_WAIT_V(0);
    PG8_BAR;
#undef PG8_SA
#undef PG8_SB
#undef PG8_STAGE
#undef PG8_LDA
#undef PG8_LDB
#undef PG8_MMA
#undef PG8_CAT8
#undef PG8_WAIT_V
#undef PG8_WAIT_L
#undef PG8_BAR
#undef PG8_SCHED
#undef PG8_AOFFS
}

typedef f32x4 AccT[2][2][4][2];
__device__ __forceinline__ u32x4 pack8(const f32x4 a, const f32x4 b) { u32x4 w; w.x = cvt_pk_bf16(a[0], a[1]); w.y = cvt_pk_bf16(a[2], a[3]); w.z = cvt_pk_bf16(b[0], b[1]); w.w = cvt_pk_bf16(b[2], b[3]); return w; }
__device__ __forceinline__ float quad_row_sum(float s) { s += __shfl_xor(s, 16); s += __shfl_xor(s, 32); return s; }

struct EpiEIn {
    static constexpr bool PERM = true;
    bf16_t* U; bf16_t* Z; const float* rsc; const float* cmax;
    __device__ __forceinline__ void operator()(const AccT& acc, const Unit& u, int wr, int wc, int fr, int fq) const {
        const int row0 = u.orow0 + wr * 64 + fr, cw = wc * 32 + 8 * fq;
        f32x4 cs[2][2];
#pragma unroll
        for (int bj = 0; bj < 2; ++bj)
#pragma unroll
            for (int n = 0; n < 2; ++n) cs[bj][n] = *(const f32x4*)(cmax + u.pn * 256 + bj * HALF + cw + 4 * n) * (1.0f / 127.0f);
#define DQ(ai, bj, m, n) (__builtin_convertvector(__builtin_bit_cast(i32x4v, acc[ai][bj][m][n]), f32x4) * (cs[bj][n] * rs))
        if (u.pn < 4) {
#pragma unroll
            for (int ai = 0; ai < 2; ++ai)
#pragma unroll
                for (int m = 0; m < 4; ++m) { const int row = row0 + ai * HALF + m * 16; const float rs = rsc[row]; bf16_t* rp = U + (size_t)row * 1024 + u.pn * 256 + cw;
#pragma unroll
                    for (int bj = 0; bj < 2; ++bj) *(u32x4*)(rp + bj * HALF) = pack8(DQ(ai, bj, m, 0), DQ(ai, bj, m, 1)); }
        } else {
            const int cb = (u.pn - 4) * 128 + cw;
#pragma unroll
            for (int ai = 0; ai < 2; ++ai)
#pragma unroll
                for (int m = 0; m < 4; ++m) { const int row = row0 + ai * HALF + m * 16; const float rs = rsc[row]; f32x4 z0, z1; const f32x4 a0 = DQ(ai, 0, m, 0), a1 = DQ(ai, 0, m, 1), g0 = DQ(ai, 1, m, 0), g1 = DQ(ai, 1, m, 1);
#pragma unroll
                    for (int j = 0; j < 4; ++j) { z0[j] = a0[j] * sigmoidf_(g0[j]); z1[j] = a1[j] * sigmoidf_(g1[j]); }
                    *(u32x4*)(Z + (size_t)row * 1024 + cb) = pack8(z0, z1); }
        }
#undef DQ
    }
};
struct EpiSwiGLU {
    static constexpr bool PERM = true;
    bf16_t* O; int ldo;
    __device__ __forceinline__ void operator()(const AccT& acc, const Unit& u, int wr, int wc, int fr, int fq) const {
        const int row0 = u.orow0 + wr * 64 + fr, cb = u.pn * 128 + wc * 32 + 8 * fq;
#pragma unroll
        for (int ai = 0; ai < 2; ++ai)
#pragma unroll
            for (int m = 0; m < 4; ++m) { f32x4 z0, z1;
#pragma unroll
                for (int j = 0; j < 4; ++j) { z0[j] = siluf_(acc[ai][0][m][0][j]) * acc[ai][1][m][0][j]; z1[j] = siluf_(acc[ai][0][m][1][j]) * acc[ai][1][m][1][j]; }
                *(u32x4*)(O + (size_t)(row0 + ai * HALF + m * 16) * ldo + cb) = pack8(z0, z1); }
    }
};
struct EpiSwiGLUi8 {
    static constexpr bool PERM = true;
    bf16_t* O; int ldo; const float* rsc; const float* cmax; float sout8;
    __device__ __forceinline__ void operator()(const AccT& acc, const Unit& u, int wr, int wc, int fr, int fq) const {
        const int row0 = u.orow0 + wr * 64 + fr, cb = u.pn * 128 + wc * 32 + 8 * fq, nb = u.pn * 256 + wc * 32 + 8 * fq;
        f32x4 cg0 = *(const f32x4*)(cmax + nb) * (1.0f / 127.0f), cg1 = *(const f32x4*)(cmax + nb + 4) * (1.0f / 127.0f), cu0 = *(const f32x4*)(cmax + nb + 128) * (1.0f / 127.0f), cu1 = *(const f32x4*)(cmax + nb + 132) * (1.0f / 127.0f);
#pragma unroll
        for (int ai = 0; ai < 2; ++ai)
#pragma unroll
            for (int m = 0; m < 4; ++m) { const int row = row0 + ai * HALF + m * 16; const float rs = rsc[row]; f32x4 z0, z1;
                const i32x4v g0 = __builtin_bit_cast(i32x4v, acc[ai][0][m][0]), g1 = __builtin_bit_cast(i32x4v, acc[ai][0][m][1]), u0 = __builtin_bit_cast(i32x4v, acc[ai][1][m][0]), u1 = __builtin_bit_cast(i32x4v, acc[ai][1][m][1]);
#pragma unroll
                for (int j = 0; j < 4; ++j) { z0[j] = siluf_((float)g0[j] * (rs * cg0[j])) * ((float)u0[j] * (rs * cu0[j])); z1[j] = siluf_((float)g1[j] * (rs * cg1[j])) * ((float)u1[j] * (rs * cu1[j])); }
                if (sout8 > 0.f) { u32x2 w; w.x = cvt4_fp8(z0[0] * sout8, z0[1] * sout8, z0[2] * sout8, z0[3] * sout8); w.y = cvt4_fp8(z1[0] * sout8, z1[1] * sout8, z1[2] * sout8, z1[3] * sout8); *(u32x2*)((unsigned char*)O + (size_t)row * ldo + cb) = w; }
                else *(u32x4*)(O + (size_t)row * ldo + cb) = pack8(z0, z1);
                __builtin_amdgcn_sched_barrier(0); }
    }
};
struct EpiSwiGLUi8M {
    static constexpr bool PERM = true;
    unsigned char* O; int ldo; const float* rsc; const float* cmax; float sout8;
    __device__ __forceinline__ void operator()(const AccT& acc, const Unit& u, int wr, int wc, int fr, int fq) const {
        const int rl0 = wr * 64 + fr, cb = u.pn * 128 + wc * 32 + 8 * fq, nb = u.g * 14336 + u.pn * 256 + wc * 32 + 8 * fq;
        const float* rs_p = rsc + (size_t)u.g * ML + u.pm * BM;
        f32x4 cg0 = *(const f32x4*)(cmax + nb) * (1.0f / 127.0f), cg1 = *(const f32x4*)(cmax + nb + 4) * (1.0f / 127.0f), cu0 = *(const f32x4*)(cmax + nb + 128) * (1.0f / 127.0f), cu1 = *(const f32x4*)(cmax + nb + 132) * (1.0f / 127.0f);
#pragma unroll
        for (int ai = 0; ai < 2; ++ai)
#pragma unroll
            for (int m = 0; m < 4; ++m) { const int rl = rl0 + ai * HALF + m * 16; const float rs = rs_p[rl]; f32x4 z0, z1;
                const i32x4v g0 = __builtin_bit_cast(i32x4v, acc[ai][0][m][0]), g1 = __builtin_bit_cast(i32x4v, acc[ai][0][m][1]), u0 = __builtin_bit_cast(i32x4v, acc[ai][1][m][0]), u1 = __builtin_bit_cast(i32x4v, acc[ai][1][m][1]);
#pragma unroll
                for (int j = 0; j < 4; ++j) { z0[j] = siluf_((float)g0[j] * (rs * cg0[j])) * ((float)u0[j] * (rs * cu0[j])); z1[j] = siluf_((float)g1[j] * (rs * cg1[j])) * ((float)u1[j] * (rs * cu1[j])); }
                u32x2 w; w.x = cvt4_fp8(z0[0] * sout8, z0[1] * sout8, z0[2] * sout8, z0[3] * sout8); w.y = cvt4_fp8(z1[0] * sout8, z1[1] * sout8, z1[2] * sout8, z1[3] * sout8);
                *(u32x2*)(O + (size_t)(u.orow0 + rl) * ldo + cb) = w;
                __builtin_amdgcn_sched_barrier(0); }
    }
};
struct EpiSwiGLU8 {
    static constexpr bool PERM = true;
    unsigned char* O; int ldo; float sin_, sout;
    __device__ __forceinline__ void operator()(const AccT& acc, const Unit& u, int wr, int wc, int fr, int fq) const {
        const int row0 = u.orow0 + wr * 64 + fr, cb = u.pn * 128 + wc * 32 + 8 * fq;
#pragma unroll
        for (int ai = 0; ai < 2; ++ai)
#pragma unroll
            for (int m = 0; m < 4; ++m) { f32x4 z0, z1;
#pragma unroll
                for (int j = 0; j < 4; ++j) { z0[j] = siluf_(acc[ai][0][m][0][j] * sin_) * (acc[ai][1][m][0][j] * (sin_ * sout)); z1[j] = siluf_(acc[ai][0][m][1][j] * sin_) * (acc[ai][1][m][1][j] * (sin_ * sout)); }
                u32x2 w; w.x = cvt4_fp8(z0[0], z0[1], z0[2], z0[3]); w.y = cvt4_fp8(z1[0], z1[1], z1[2], z1[3]);
                *(u32x2*)(O + (size_t)(row0 + ai * HALF + m * 16) * ldo + cb) = w; __builtin_amdgcn_sched_barrier(0); }
    }
};
template <class BT>
struct EpiResT {
    static constexpr bool PERM = false;
    const BT* bl; const BT* bc; bf16_t* out; const float* gate; float scale;
    static __device__ __forceinline__ f32x4 ldb(const float* p) { return *(const f32x4*)p; }
    static __device__ __forceinline__ f32x4 ldb(const bf16_t* p) { return ld4_bf(p); }
    __device__ __forceinline__ void operator()(const AccT& acc, const Unit& u, int wr, int wc, int fr, int fq) const {
        const int cnd = cond_of(u.orow0);
        const BT* bp = (u.orow0 < ML) ? bl + (size_t)u.orow0 * DM : bc + (size_t)(u.orow0 - ML) * DM;
        bf16_t* op = out + (size_t)u.orow0 * DM;
        const int rl0 = wr * 64 + fr, col0 = u.pn * BM + wc * 32 + 4 * fq;
        f32x4 gv[2][2];
#pragma unroll
        for (int bj = 0; bj < 2; ++bj)
#pragma unroll
            for (int n = 0; n < 2; ++n) gv[bj][n] = *(const f32x4*)(gate + (size_t)cnd * NMOD + col0 + bj * HALF + n * 16) * scale;
#pragma unroll
        for (int ai = 0; ai < 2; ++ai)
#pragma unroll
            for (int m = 0; m < 4; ++m) { const size_t off = (size_t)(rl0 + ai * HALF + m * 16) * DM + col0;
#pragma unroll
                for (int bj = 0; bj < 2; ++bj)
#pragma unroll
                    for (int n = 0; n < 2; ++n) { const f32x4 bs = ldb(bp + off + bj * HALF + n * 16); st4_bf(op + off + bj * HALF + n * 16, bs + gv[bj][n] * acc[ai][bj][m][n]); }
                asm volatile("" ::: "memory"); }
    }
};
struct EpiPart {
    static constexpr bool PERM = false;
    float* part; const float* gate; float scale;
    __device__ __forceinline__ void operator()(const AccT& acc, const Unit& u, int wr, int wc, int fr, int fq) const {
        const int rl0 = wr * 64 + fr, col0 = u.pn * BM + wc * 32 + 4 * fq;
        float* op = part + ((size_t)u.g * MC + (u.orow0 - ML)) * DM;
        f32x4 gv[2][2];
#pragma unroll
        for (int bj = 0; bj < 2; ++bj)
#pragma unroll
            for (int n = 0; n < 2; ++n) gv[bj][n] = *(const f32x4*)(gate + (size_t)4 * NMOD + col0 + bj * HALF + n * 16) * scale;
#pragma unroll
        for (int ai = 0; ai < 2; ++ai)
#pragma unroll
            for (int m = 0; m < 4; ++m) { const size_t off = (size_t)(rl0 + ai * HALF + m * 16) * DM + col0;
#pragma unroll
                for (int bj = 0; bj < 2; ++bj)
#pragma unroll
                    for (int n = 0; n < 2; ++n) *(f32x4*)(op + off + bj * HALF + n * 16) = gv[bj][n] * acc[ai][bj][m][n]; }
    }
};
struct EpiOIn {
    static constexpr bool PERM = true;
    bf16_t *CQ, *CKV, *GU, *GV; unsigned char* KB; float *ssq_q, *ssq_kv, *zs1, *zs2; const float* rope; const float* rsc; const float* cmax;
    __device__ __forceinline__ void operator()(const AccT& acc, const Unit& u, int wr, int wc, int fr, int fq) const {
        const int row0 = u.orow0 + wr * 64 + fr, cw = wc * 32 + 8 * fq; const int pn = u.pn;
        f32x4 cs[2][2];
#pragma unroll
        for (int bj = 0; bj < 2; ++bj)
#pragma unroll
            for (int n = 0; n < 2; ++n) cs[bj][n] = *(const f32x4*)(cmax + pn * 256 + bj * HALF + cw + 4 * n) * (1.0f / 127.0f);
#define DQ(ai, bj, m, n) (__builtin_convertvector(__builtin_bit_cast(i32x4v, acc[ai][bj][m][n]), f32x4) * (cs[bj][n] * rs))
        if (pn < 4) {
            bf16_t* O = pn < 2 ? CQ : CKV; float* ss = pn < 2 ? ssq_q : ssq_kv; const int cb = (pn & 1) * 256 + cw;
#pragma unroll
            for (int ai = 0; ai < 2; ++ai)
#pragma unroll
                for (int m = 0; m < 4; ++m) { const int row = row0 + ai * HALF + m * 16; const float rs = rsc[row]; float s = 0.f;
#pragma unroll
                    for (int bj = 0; bj < 2; ++bj) { const f32x4 v0 = DQ(ai, bj, m, 0), v1 = DQ(ai, bj, m, 1); *(u32x4*)(O + (size_t)row * 512 + cb + bj * HALF) = pack8(v0, v1); s += sq4(v0) + sq4(v1); }
                    s = quad_row_sum(s); if (fq == 0) unsafeAtomicAdd(ss + row, s); }
        } else if (pn == 4) {
            if (wc < 2) {
                const bool lat = u.orow0 < ML;
#pragma unroll
                for (int ai = 0; ai < 2; ++ai)
#pragma unroll
                    for (int m = 0; m < 4; ++m) { const int row = row0 + ai * HALF + m * 16; const float rs = rsc[row]; f32x4 x1 = DQ(ai, 0, m, 0), x2 = DQ(ai, 0, m, 1), o1 = x1, o2 = x2;
                        if (lat) { const int t = row & 4095, pos = wc ? (t & 63) : (t >> 6); const f32x4 cs0 = *(const f32x4*)(rope + (pos * 16 + 4 * fq) * 2), cs1 = *(const f32x4*)(rope + (pos * 16 + 4 * fq) * 2 + 4);
                            const float c_[4] = {cs0[0], cs0[2], cs1[0], cs1[2]}, s_[4] = {cs0[1], cs0[3], cs1[1], cs1[3]};
#pragma unroll
                            for (int j = 0; j < 4; ++j) { o1[j] = x1[j] * c_[j] - x2[j] * s_[j]; o2[j] = x2[j] * c_[j] + x1[j] * s_[j]; } }
                        const unsigned w1 = cvt4_fp8(o1[0], o1[1], o1[2], o1[3]), w2 = cvt4_fp8(o2[0], o2[1], o2[2], o2[3]);
                        unsigned char* kp = KB + (size_t)krow_of(row) * 1536 + 128 + wc * 32 + 4 * fq;
#pragma unroll
                        for (int h = 0; h < 8; ++h) { *(unsigned*)(kp + h * 192) = w1; *(unsigned*)(kp + h * 192 + 16) = w2; } }
            }
        } else {
            const bool isv = pn >= 9; bf16_t* O = isv ? GV : GU; const int cb = ((pn - 5) & 3) * 256 + cw;
#pragma unroll
            for (int ai = 0; ai < 2; ++ai)
#pragma unroll
                for (int m = 0; m < 4; ++m) { const int row = row0 + ai * HALF + m * 16; const float rs = rsc[row]; float s1 = 0.f, s2 = 0.f;
#pragma unroll
                    for (int bj = 0; bj < 2; ++bj) { f32x4 g0, g1; const f32x4 v0 = DQ(ai, bj, m, 0), v1 = DQ(ai, bj, m, 1);
#pragma unroll
                        for (int j = 0; j < 4; ++j) { g0[j] = gelu_tanh(v0[j]); g1[j] = gelu_tanh(v1[j]); }
                        *(u32x4*)(O + (size_t)row * 1024 + cb + bj * HALF) = pack8(g0, g1); s1 += sum4(g0) + sum4(g1); s2 += sq4(g0) + sq4(g1); }
                    if (isv) { s1 = quad_row_sum(s1); s2 = quad_row_sum(s2); if (fq == 0) { unsafeAtomicAdd(zs1 + row, s1); unsafeAtomicAdd(zs2 + row, s2); } } }
        }
#undef DQ
    }
};
struct EpiQ {
    static constexpr bool PERM = true;
    unsigned char* Q; const float* ssq_q; const float* rope;
    __device__ __forceinline__ void operator()(const AccT& acc, const Unit& u, int wr, int wc, int fr, int fq) const {
        const int row0 = u.orow0 + wr * 64 + fr;
#pragma unroll
        for (int ai = 0; ai < 2; ++ai)
#pragma unroll
            for (int m = 0; m < 4; ++m) { const int row = row0 + ai * HALF + m * 16; const float rs = __builtin_amdgcn_rsqf(ssq_q[row] * (1.0f / 512.0f) + EPS) * (QSCALE * Q8S);
                unsigned char* qp = Q + (size_t)row * 1536;
                if (u.pn < 4) {
#pragma unroll
                    for (int bj = 0; bj < 2; ++bj) { const f32x4 a0 = acc[ai][bj][m][0] * rs, a1 = acc[ai][bj][m][1] * rs; u32x2 w; w.x = cvt4_fp8(a0[0], a0[1], a0[2], a0[3]); w.y = cvt4_fp8(a1[0], a1[1], a1[2], a1[3]);
                        *(u32x2*)(qp + (2 * u.pn + bj) * 192 + wc * 32 + 8 * fq) = w; }
                } else {
                    const int t = row & 4095, ax = wc & 1, pos = ax ? (t & 63) : (t >> 6);
                    const f32x4 cs0 = *(const f32x4*)(rope + (pos * 16 + 4 * fq) * 2), cs1 = *(const f32x4*)(rope + (pos * 16 + 4 * fq) * 2 + 4);
                    const float c_[4] = {cs0[0], cs0[2], cs1[0], cs1[2]}, s_[4] = {cs0[1], cs0[3], cs1[1], cs1[3]};
#pragma unroll
                    for (int bj = 0; bj < 2; ++bj) { const int hh = 4 * (u.pn - 4) + 2 * bj + (wc >> 1); const f32x4 x1 = acc[ai][bj][m][0] * rs, x2 = acc[ai][bj][m][1] * rs; f32x4 o1, o2;
#pragma unroll
                        for (int j = 0; j < 4; ++j) { o1[j] = x1[j] * c_[j] - x2[j] * s_[j]; o2[j] = x2[j] * c_[j] + x1[j] * s_[j]; }
                        unsigned char* p = qp + hh * 192 + 128 + ax * 32 + 4 * fq; *(unsigned*)p = cvt4_fp8(o1[0], o1[1], o1[2], o1[3]); *(unsigned*)(p + 16) = cvt4_fp8(o2[0], o2[1], o2[2], o2[3]); }
                } }
    }
};
struct EpiKV {
    static constexpr bool PERM = true;
    unsigned char* KB; unsigned char* VB; const float* ssq_kv;
    __device__ __forceinline__ void operator()(const AccT& acc, const Unit& u, int wr, int wc, int fr, int fq) const {
        const int row0 = u.orow0 + wr * 64 + fr, cw = wc * 32 + 8 * fq;
#pragma unroll
        for (int ai = 0; ai < 2; ++ai)
#pragma unroll
            for (int m = 0; m < 4; ++m) { const int row = row0 + ai * HALF + m * 16; const float rs = __builtin_amdgcn_rsqf(ssq_kv[row] * (1.0f / 512.0f) + EPS); const int kr = krow_of(row);
                { const f32x4 a0 = acc[ai][0][m][0] * rs, a1 = acc[ai][0][m][1] * rs; u32x2 w; w.x = cvt4_fp8(a0[0], a0[1], a0[2], a0[3]); w.y = cvt4_fp8(a1[0], a1[1], a1[2], a1[3]); *(u32x2*)(KB + (size_t)kr * 1536 + u.pn * 192 + cw) = w; }
                { const int bb = row < ML ? (row >> 12) : ((row - ML) >> 8), key = kr - bb * KVL;
                  const unsigned vo = (unsigned)(((bb * 8 + u.pn) * 128 + cw) * KVL + (key & ~63) + v_pos(key & 63));
                  const f32x4 a0 = acc[ai][1][m][0] * rs, a1 = acc[ai][1][m][1] * rs; const unsigned w0 = cvt4_fp8(a0[0], a0[1], a0[2], a0[3]), w1 = cvt4_fp8(a1[0], a1[1], a1[2], a1[3]);
#pragma unroll
                  for (int j = 0; j < 4; ++j) { VB[vo + (unsigned)(j * KVL)] = (unsigned char)(w0 >> (8 * j)); VB[vo + (unsigned)((4 + j) * KVL)] = (unsigned char)(w1 >> (8 * j)); } } }
    }
};
struct EpiQKV {
    static constexpr bool PERM = true;
    EpiQ q; EpiKV kv;
    __device__ __forceinline__ void operator()(const AccT& acc, const Unit& u, int wr, int wc, int fr, int fq) const { if (u.g == 0) q(acc, u, wr, wc, fr, fq); else kv(acc, u, wr, wc, fr, fq); }
};
struct EpiBf16 {
    static constexpr bool PERM = true;
    bf16_t* O; int ldo; float scale;
    __device__ __forceinline__ void operator()(const AccT& acc, const Unit& u, int wr, int wc, int fr, int fq) const {
        const int row0 = u.orow0 + wr * 64 + fr, cb = u.pn * 256 + wc * 32 + 8 * fq;
#pragma unroll
        for (int ai = 0; ai < 2; ++ai)
#pragma unroll
            for (int m = 0; m < 4; ++m) { bf16_t* rp = O + (size_t)(row0 + ai * HALF + m * 16) * ldo + cb;
#pragma unroll
                for (int bj = 0; bj < 2; ++bj) *(u32x4*)(rp + bj * HALF) = pack8(acc[ai][bj][m][0] * scale, acc[ai][bj][m][1] * scale); }
    }
};
}

namespace att {
constexpr int DQK = 192, DV = 128, NW = 8, QBLK = 32, KVBLK = 64;
constexpr int LDQ = 1536, LDKK = 1536, LDVV = 1024, LDO = 2048;
constexpr float THR = 8.0f;
constexpr int KROW = 208;
constexpr int VROW = 80;
constexpr int SHM_V = DV * VROW, SHM_K = KVBLK * KROW;
constexpr int NBUF = 3;
constexpr int SHM_ATTN = NBUF * SHM_V + NBUF * SHM_K + NW * 64 * 4;
#define KSWZ(row, colB) ((row) * 384 + ((colB) ^ (((row) & 7) << 4)))
#define SBAR() __builtin_amdgcn_sched_barrier(0)
__device__ __forceinline__ int crow(int r, int hi) { return (r & 3) + 8 * (r >> 2) + 4 * hi; }
__device__ __forceinline__ unsigned cvtpk(float lo, float hi) { unsigned r; asm volatile("v_cvt_pk_bf16_f32 %0, %1, %2" : "=v"(r) : "v"(lo), "v"(hi)); return r; }
__device__ __forceinline__ void partialSM(f32x16& p0, f32x16& p1, float& m_reg, float& mn, float& alpha) {
    float pmax;
    { float ma = fmaxf(p0[0], p0[1]), mb = fmaxf(p0[8], p0[9]), mc = fmaxf(p1[0], p1[1]), md = fmaxf(p1[8], p1[9]);
#pragma unroll
      for (int r = 2; r < 8; r += 2) { ma = fmaxf(fmaxf(ma, p0[r]), p0[r + 1]); mb = fmaxf(fmaxf(mb, p0[8 + r]), p0[9 + r]); mc = fmaxf(fmaxf(mc, p1[r]), p1[r + 1]); md = fmaxf(fmaxf(md, p1[8 + r]), p1[9 + r]); }
      pmax = fmaxf(fmaxf(ma, mb), fmaxf(mc, md)); }
    { auto rr = __builtin_amdgcn_permlane32_swap(__float_as_uint(pmax), __float_as_uint(pmax), false, false);
      pmax = fmaxf(__uint_as_float(rr[0]), __uint_as_float(rr[1])); }
    if (__builtin_expect(__all(pmax - m_reg <= THR), 1)) { mn = m_reg; alpha = 1.f; }
    else { mn = fmaxf(m_reg, pmax); alpha = __builtin_amdgcn_exp2f(m_reg - mn); m_reg = mn; }
#pragma unroll
    for (int r = 0; r < 16; ++r) p0[r] = p0[r] - mn;
#pragma unroll
    for (int r = 0; r < 16; ++r) p1[r] = p1[r] - mn;
#pragma unroll
    for (int r = 0; r < 16; ++r) p0[r] = __builtin_amdgcn_exp2f(p0[r]);
}
__device__ __forceinline__ void partialSM_shift(f32x16& p0, f32x16& p1, float& m_reg, float& alpha) {
    float pmax;
    { float ma = fmaxf(p0[0], p0[1]), mb = fmaxf(p0[8], p0[9]), mc = fmaxf(p1[0], p1[1]), md = fmaxf(p1[8], p1[9]);
#pragma unroll
      for (int r = 2; r < 8; r += 2) { ma = fmaxf(fmaxf(ma, p0[r]), p0[r + 1]); mb = fmaxf(fmaxf(mb, p0[8 + r]), p0[9 + r]); mc = fmaxf(fmaxf(mc, p1[r]), p1[r + 1]); md = fmaxf(fmaxf(md, p1[8 + r]), p1[9 + r]); }
      pmax = fmaxf(fmaxf(ma, mb), fmaxf(mc, md)); }
    { auto rr = __builtin_amdgcn_permlane32_swap(__float_as_uint(pmax), __float_as_uint(pmax), false, false);
      pmax = fmaxf(__uint_as_float(rr[0]), __uint_as_float(rr[1])); }
    if (__builtin_expect(__all(pmax <= THR), 1)) { alpha = 1.f; }
    else { const float d = fmaxf(pmax, 0.f); alpha = __builtin_amdgcn_exp2f(-d); m_reg += d;
#pragma unroll
        for (int r = 0; r < 16; ++r) p0[r] = p0[r] - d;
#pragma unroll
        for (int r = 0; r < 16; ++r) p1[r] = p1[r] - d; }
#pragma unroll
    for (int r = 0; r < 16; ++r) p0[r] = __builtin_amdgcn_exp2f(p0[r]);
}
__device__ __forceinline__ void finishSM(f32x16& p0, f32x16& p1, float alpha, float& l_reg, pg8::i32x8& pa) {
#pragma unroll
    for (int r = 0; r < 16; ++r) p1[r] = __builtin_amdgcn_exp2f(p1[r]);
    float ps;
    { float sa = p0[0] + p0[1], sb = p0[8] + p0[9], sc = p1[0] + p1[1], sd = p1[8] + p1[9];
#pragma unroll
      for (int r = 2; r < 8; ++r) { sa += p0[r]; sb += p0[8 + r]; sc += p1[r]; sd += p1[8 + r]; }
      ps = (sa + sb) + (sc + sd); }
    { auto rr = __builtin_amdgcn_permlane32_swap(__float_as_uint(ps), __float_as_uint(ps), false, false);
      ps = __uint_as_float(rr[0]) + __uint_as_float(rr[1]); }
    l_reg = l_reg * alpha + ps;
#define PK8(P, B) ({ int w_ = 0; w_ = __builtin_amdgcn_cvt_pk_fp8_f32(P[B], P[B + 1], w_, false); w_ = __builtin_amdgcn_cvt_pk_fp8_f32(P[B + 2], P[B + 3], w_, true); w_; })
    pa = (pg8::i32x8){PK8(p0, 0), PK8(p0, 4), PK8(p0, 8), PK8(p0, 12), PK8(p1, 0), PK8(p1, 4), PK8(p1, 8), PK8(p1, 12)};
#undef PK8
}
__device__ __forceinline__ void qkt(f32x16& p0, f32x16& p1, const int kb, const pg8::i32x8 (&qf)[3], float minit) {
#pragma unroll
    for (int r = 0; r < 16; ++r) { p0[r] = -minit; p1[r] = -minit; }
#pragma unroll
    for (int s = 0; s < 3; ++s) {
        const u32x4 a0 = *reinterpret_cast<const LAS u32x4*>((uintptr_t)(unsigned)(kb + (s * 64))), a1 = *reinterpret_cast<const LAS u32x4*>((uintptr_t)(unsigned)(kb + (s * 64 + 16)));
        const u32x4 b0 = *reinterpret_cast<const LAS u32x4*>((uintptr_t)(unsigned)(kb + (s * 64 + 32 * KROW))), b1 = *reinterpret_cast<const LAS u32x4*>((uintptr_t)(unsigned)(kb + (s * 64 + 32 * KROW + 16)));
        const pg8::i32x8 A0 = {(int)a0.x, (int)a0.y, (int)a0.z, (int)a0.w, (int)a1.x, (int)a1.y, (int)a1.z, (int)a1.w}, A1 = {(int)b0.x, (int)b0.y, (int)b0.z, (int)b0.w, (int)b1.x, (int)b1.y, (int)b1.z, (int)b1.w};
        p0 = __builtin_amdgcn_mfma_scale_f32_32x32x64_f8f6f4(A0, qf[s], p0, 0, 0, 0, 0, 0, 0);
        p1 = __builtin_amdgcn_mfma_scale_f32_32x32x64_f8f6f4(A1, qf[s], p1, 0, 0, 0, 0, 0, 0);
    }
}
__device__ __forceinline__ void pv_d0(f32x16* o, int vb, const pg8::i32x8 pa) {
#pragma unroll
    for (int d0 = 0; d0 < 4; ++d0) {
        const u32x4 x0 = *reinterpret_cast<const LAS u32x4*>((uintptr_t)(unsigned)(vb + d0 * 32 * VROW)), x1 = *reinterpret_cast<const LAS u32x4*>((uintptr_t)(unsigned)(vb + d0 * 32 * VROW + 16));
        const pg8::i32x8 vf = {(int)x0.x, (int)x0.y, (int)x0.z, (int)x0.w, (int)x1.x, (int)x1.y, (int)x1.z, (int)x1.w};
        o[d0] = __builtin_amdgcn_mfma_scale_f32_32x32x64_f8f6f4(pa, vf, o[d0], 0, 0, 0, 0, 0, 0);
    }
}

__device__ __forceinline__ void attn_body(const unsigned char* __restrict__ Qb, const unsigned char* __restrict__ Kh, const unsigned char* __restrict__ Vh, bf16_t* __restrict__ Ob, int seq, char* lds) {
    int tid = threadIdx.x; asm volatile("" : "+v"(tid));
    const int wid = tid >> 6, lane = tid & 63, r32 = lane & 31, hi = lane >> 5;
    char* V_lds = lds; char* K_lds = lds + NBUF * SHM_V;
    float* ws = (float*)(lds + NBUF * SHM_V + NBUF * SHM_K) + wid * 64; float* li_l = ws; float* al_l = ws + 32;
    float m_reg = -1e30f, l_reg = 0; f32x16 o[4]; pg8::i32x8 qf[3];
    float zf = 0.f; asm volatile("" : "+v"(zf));
#pragma unroll
    for (int d = 0; d < 4; ++d)
#pragma unroll
        for (int r = 0; r < 16; ++r) o[d][r] = zf;
    const unsigned char* Qw = Qb + (size_t)(wid * QBLK + r32) * LDQ + hi * 32;
#pragma unroll
    for (int s3 = 0; s3 < 3; ++s3) { const u32x4 x0 = *reinterpret_cast<const u32x4*>(Qw + s3 * 64), x1 = *reinterpret_cast<const u32x4*>(Qw + s3 * 64 + 16);
        qf[s3] = (pg8::i32x8){(int)x0.x, (int)x0.y, (int)x0.z, (int)x0.w, (int)x1.x, (int)x1.y, (int)x1.z, (int)x1.w}; }
    const int vd = tid >> 2, vc = tid & 3; const unsigned vgo = (unsigned)(vd * 4352 + vc * 16); const int vlo = vd * VROW + vc * 16;
    const int id1 = tid < 256 ? tid + 512 : tid;
    const int kr0 = tid / 12, kc0 = tid % 12, kr1 = id1 / 12, kc1 = id1 % 12;
    const unsigned kgo0 = (unsigned)(kr0 * LDKK + kc0 * 16), kgo1 = (unsigned)(kr1 * LDKK + kc1 * 16); const int klo0 = kr0 * KROW + kc0 * 16, klo1 = kr1 * KROW + kc1 * 16;
    const int vb0 = (int)(uintptr_t)V_lds + r32 * VROW + hi * 32;
    const int kb = (int)(uintptr_t)K_lds + r32 * KROW + hi * 32;
    u32x4 sv0, sk0, sk1;
#define SLOAD(k0) do { sv0 = *reinterpret_cast<const u32x4*>(Vh + (size_t)(k0) + vgo); \
    const unsigned char* kp_ = Kh + (size_t)(k0) * LDKK; sk0 = *reinterpret_cast<const u32x4*>(kp_ + kgo0); sk1 = *reinterpret_cast<const u32x4*>(kp_ + kgo1); } while (0)
#define SWRITE(b) do { *(u32x4*)(V_lds + (b) * SHM_V + vlo) = sv0; \
    *(u32x4*)(K_lds + (b) * SHM_K + klo0) = sk0; *(u32x4*)(K_lds + (b) * SHM_K + klo1) = sk1; } while (0)
#define SWAIT() asm volatile("s_waitcnt vmcnt(0)" ::: "memory")
#define RESC(a) do { if (__any((a) < 1.f)) { if (hi == 0) al_l[r32] = (a); asm volatile("s_waitcnt lgkmcnt(0)" ::: "memory"); \
    _Pragma("unroll") for (int d = 0; d < 4; ++d) _Pragma("unroll") for (int r = 0; r < 16; ++r) o[d][r] *= al_l[crow(r, hi)]; } } while (0)
    f32x16 pA0, pA1, pB0, pB1; float mnA, mnB, alA, alB; pg8::i32x8 pa; const int NT = seq / KVBLK;
    const int klast = (NT - 1) * KVBLK;
    SLOAD(0); SWAIT(); SWRITE(0); SLOAD(KVBLK); __syncthreads();
    SWAIT(); SWRITE(1); SLOAD(2 * KVBLK); SBAR();
    qkt(pA0, pA1, kb, qf, zf); partialSM(pA0, pA1, m_reg, mnA, alA);
    __syncthreads();
    int bm = 0, bc = 1, bn = 2;
    for (int j = 1; j + 1 < NT; j += 2) {
        SWAIT(); SWRITE(bn); SLOAD(min((j + 2) * KVBLK, klast)); SBAR();
        qkt(pB0, pB1, kb + bc * SHM_K, qf, m_reg);
        finishSM(pA0, pA1, alA, l_reg, pa); SBAR();
        pv_d0(o, vb0 + bm * SHM_V, pa); partialSM_shift(pB0, pB1, m_reg, alB);
        RESC(alB); __syncthreads();
        SWAIT(); SWRITE(bm); SLOAD(min((j + 3) * KVBLK, klast)); SBAR();
        qkt(pA0, pA1, kb + bn * SHM_K, qf, m_reg);
        finishSM(pB0, pB1, alB, l_reg, pa); SBAR();
        pv_d0(o, vb0 + bc * SHM_V, pa); partialSM_shift(pA0, pA1, m_reg, alA);
        RESC(alA); __syncthreads();
        { const int t_ = bm; bm = bn; bn = bc; bc = t_; }
    }
    SWAIT(); SBAR();
    qkt(pB0, pB1, kb + bc * SHM_K, qf, m_reg);
    finishSM(pA0, pA1, alA, l_reg, pa); SBAR();
    pv_d0(o, vb0 + bm * SHM_V, pa); partialSM_shift(pB0, pB1, m_reg, alB);
    RESC(alB);
    finishSM(pB0, pB1, alB, l_reg, pa); SBAR();
    pv_d0(o, vb0 + bc * SHM_V, pa);
    if (hi == 0) li_l[r32] = l_reg; asm volatile("s_waitcnt lgkmcnt(0)" ::: "memory");
    int le = lane; asm volatile("" : "+v"(le));
    const int r32e = le & 31, hie = le >> 5;
    bf16_t* Ow = Ob + (size_t)(wid * QBLK) * LDO;
#pragma unroll
    for (int r = 0; r < 16; ++r) { const int orow = crow(r, hie); const float rli = __builtin_amdgcn_rcpf(li_l[orow]); const unsigned ob = (unsigned)(orow * LDO + r32e);
#pragma unroll
        for (int d0 = 0; d0 < 4; ++d0) { const unsigned w = cvtpk(o[d0][r] * rli, 0.f); Ow[ob + d0 * 32] = (bf16_t)(w & 0xffffu); } }
#undef SLOAD
#undef SWRITE
#undef SWAIT
#undef RESC
}
}

struct Params {
    const float* in[35];
    float* out; unsigned char* ws;
    int ph_lo, ph_hi, use_bar, grid;
};
constexpr int NPHASE = 17;
typedef __attribute__((address_space(1))) const float GF;
struct InTbl { GF* const* p; __device__ __forceinline__ const float* operator[](int i) const { return (const float*)p[i]; } };
struct Ctx { InTbl in; float* out; unsigned char* ws; };
__device__ __forceinline__ GF* const* in_tbl() { GF* const* p = (GF* const*)__builtin_amdgcn_kernarg_segment_ptr(); asm volatile("" : "+s"(p)); return p; }

__device__ __forceinline__ int rope_src(int p) { const int fq = p >> 3, nn = (p >> 2) & 1, jj = p & 3; return nn * 16 + 4 * fq + jj; }
struct TD { const float* p; const float* ks; unsigned char* dst; int ld; unsigned dpitch; float wscale; int fp8; const float* cm; };
constexpr int TR_I0 = 12 * 16, TR_I1 = 8 * 8, TR_I2 = 44 * 16, TR_I3 = 8 * 44, TR_I4 = 13 * 16, TR_I5 = 6 * 4, TR_I6 = 8 * 4, TR_I7 = 8 * 16, TR_I8 = 448 * 16, TR_I9 = 64 * 56;
constexpr int TR_NMAIN = TR_I0 + TR_I1 + TR_I2 + TR_I3 + TR_I4 + TR_I5 + TR_I6 + TR_I7;
constexpr int TR_NMOE = TR_I8 + TR_I9;
__device__ __forceinline__ TD tr_get(const Ctx& P, int it, int lane, int wave) {
    unsigned char* ws = P.ws;
    TD t; int r = it; const int q4 = 4 * lane, kw = 16 * wave; t.ks = nullptr; t.wscale = 1.0f; t.fp8 = 0; t.cm = nullptr;
    if (r < TR_I0) { const int n = (r % 12) * 256 + q4, k0 = (r / 12) * 128; int col;
        if (n < 1024) col = n; else { const int q = n - 1024, j = q >> 8, half = (q >> 7) & 1, w = q & 127; col = 1024 + half * 1024 + j * 128 + w; }
        t.p = P.in[8] + (size_t)(k0 + kw) * 3072 + col; t.ld = 3072; t.fp8 = 2; t.cm = (const float*)(ws + WS_CTL) + CW_CMAX_EIN + n; t.dst = ws + WS_WEIN + (size_t)(n - q4) * 2048 + k0; t.dpitch = 2048; return t; } r -= TR_I0;
    if (r < TR_I1) { const int n = (r % 8) * 256 + q4, k0 = (r / 8) * 128;
        t.p = P.in[15] + (size_t)(1024 + k0 + kw) * DM + n; t.ld = DM; t.dst = ws + WS_WEOUT + ((size_t)(n - q4) * 2048 + 1024 + k0) * 2; t.dpitch = 4096; return t; } r -= TR_I1;
    if (r < TR_I2) { const int n = (r % 44) * 256 + q4, k0 = (r / 44) * 128; const int j = n >> 8, half = (n >> 7) & 1, w = n & 127;
        t.p = (half ? P.in[17] : P.in[16]) + (size_t)(k0 + kw) * DFF + j * 128 + w; t.ld = DFF; t.fp8 = 2; t.cm = (const float*)(ws + WS_CTL) + CW_CMAX + n;
        t.dst = ws + WS_WF1 + (size_t)(n - q4) * 2048 + k0; t.dpitch = 2048; return t; } r -= TR_I2;
    if (r < TR_I3) { const int n = (r % 8) * 256 + q4, k0 = (r / 8) * 128;
        t.p = P.in[18] + (size_t)(k0 + kw) * DM + n; t.ld = DM; t.wscale = W2S; t.fp8 = 1; t.dst = ws + WS_WF2 + (size_t)(n - q4) * DFF + k0; t.dpitch = DFF; return t; } r -= TR_I3;
    if (r < TR_I4) { const int n = (r % 13) * 256 + q4, k0 = (r / 13) * 128; int col;
        if (n < 1024) col = n; else if (n < 1088) { const int p = n - 1024; col = 1024 + (p & 32) + rope_src(p & 31); } else if (n < 1280) col = -1; else col = n - 192;
        t.p = col < 0 ? nullptr : P.in[19] + (size_t)(k0 + kw) * 3136 + col; t.ld = 3136; t.fp8 = 2; t.cm = (const float*)(ws + WS_CTL) + CW_CMAX_OIN + n; t.dst = ws + WS_WOIN + (size_t)(n - q4) * 2048 + k0; t.dpitch = 2048; return t; } r -= TR_I4;
    if (r < TR_I5) { const int n = (r % 6) * 256 + q4, k0 = (r / 6) * 128; int col;
        if (n < 1024) col = (n >> 7) * 192 + (n & 127); else { const int p = n - 1024, h = p >> 6, pp = p & 63; col = h * 192 + 128 + (pp & 32) + rope_src(pp & 31); }
        t.p = P.in[21] + (size_t)(k0 + kw) * 1536 + col; t.ld = 1536; t.ks = P.in[20] + k0 + kw; t.dst = ws + WS_WQB + ((size_t)(n - q4) * 512 + k0) * 2; t.dpitch = 1024; return t; } r -= TR_I5;
    if (r < TR_I6) { const int n = (r % 8) * 256 + q4, k0 = (r / 8) * 128;
        t.p = P.in[23] + (size_t)(k0 + kw) * DM + n; t.ld = DM; t.ks = P.in[22] + k0 + kw; t.dst = ws + WS_WKVB + ((size_t)(n - q4) * 512 + k0) * 2; t.dpitch = 1024; return t; } r -= TR_I6;
    if (r < TR_I7) { const int n = (r % 8) * 256 + q4, k0 = (r / 8) * 128;
        t.p = P.in[28] + (size_t)(k0 + kw) * DM + n; t.ld = DM; t.dst = ws + WS_WOOUT + ((size_t)(n - q4) * 2048 + k0) * 2; t.dpitch = 4096; return t; } r -= TR_I7;
    if (r < TR_I8) { const int nn = (r % 448) * 256 + q4, k0 = (r / 448) * 128; const int e = nn / 14336, n = nn % 14336, j = n >> 8, half = (n >> 7) & 1, w = n & 127;
        t.p = (half ? P.in[32] : P.in[31]) + (size_t)e * DM * DFFE + (size_t)(k0 + kw) * DFFE + j * 128 + w; t.ld = DFFE; t.fp8 = 2; t.cm = (const float*)(ws + WS_MCM) + nn;
        t.dst = ws + WS_WM1 + (size_t)(nn - q4) * 2048 + k0; t.dpitch = 2048; return t; } r -= TR_I8;
    { const int nn = (r % 64) * 256 + q4, k0 = (r / 64) * 128; const int e = nn >> 11, n = nn & 2047;
        t.p = P.in[33] + (size_t)e * DFFE * DM + (size_t)(k0 + kw) * DM + n; t.ld = DM; t.wscale = W2S; t.fp8 = 1;
        t.dst = ws + WS_WM2 + (size_t)(nn - q4) * DFFE + k0; t.dpitch = DFFE; return t; }
}
template <bool POLL>
__device__ __forceinline__ int tr_run(const Ctx& P, LAS unsigned char* lds, int base, int first, int step, int j0, int nitems, unsigned* cnt, unsigned target) {
    const int tid = threadIdx.x, lane = tid & 63, wave = __builtin_amdgcn_readfirstlane(tid >> 6);
    volatile LAS unsigned* flag = (volatile LAS unsigned*)(lds + LDS_MISC + 2048);
    int j = j0;
    if (first + j * step >= nitems) return j;
    if (POLL) { if (tid == 0) flag[0] = (__hip_atomic_load(cnt, __ATOMIC_RELAXED, __HIP_MEMORY_SCOPE_AGENT) >= target) ? 1u : 0u; __syncthreads(); if (flag[0]) return j; }
    f32x4 v[16];
#define TR_LOAD(td) do { if ((td).p) { _Pragma("unroll") for (int i = 0; i < 16; ++i) v[i] = __builtin_nontemporal_load((const f32x4*)((td).p + (size_t)i * (td).ld)); } \
        else { _Pragma("unroll") for (int i = 0; i < 16; ++i) v[i] = (f32x4){0.f, 0.f, 0.f, 0.f}; } } while (0)
    TD cur = tr_get(P, base + first + j * step, lane, wave); TR_LOAD(cur);
    const int sw = lane & 7;
    for (;;) {
        unsigned pollv = 0u;
        if (POLL && tid == 0) pollv = __hip_atomic_load(cnt, __ATOMIC_RELAXED, __HIP_MEMORY_SCOPE_AGENT);
        if (cur.ks) {
#pragma unroll
            for (int i = 0; i < 16; ++i) v[i] *= cur.ks[i]; }
        if (cur.fp8 == 2) {
            const f32x4 cm4 = *(const f32x4*)cur.cm;
#pragma unroll
            for (int c = 0; c < 4; ++c) { u32x4 w; const float s_ = 127.0f / fmaxf(cm4[c], 1e-30f);
                w.x = cvt4_i8(v[0][c] * s_, v[1][c] * s_, v[2][c] * s_, v[3][c] * s_); w.y = cvt4_i8(v[4][c] * s_, v[5][c] * s_, v[6][c] * s_, v[7][c] * s_);
                w.z = cvt4_i8(v[8][c] * s_, v[9][c] * s_, v[10][c] * s_, v[11][c] * s_); w.w = cvt4_i8(v[12][c] * s_, v[13][c] * s_, v[14][c] * s_, v[15][c] * s_);
                *(LAS u32x4*)(lds + (4 * lane + c) * 128 + ((wave ^ sw) << 4)) = w; }
        } else if (cur.fp8) {
#pragma unroll
            for (int c = 0; c < 4; ++c) { u32x4 w; const float s_ = cur.wscale;
                w.x = cvt4_fp8(v[0][c] * s_, v[1][c] * s_, v[2][c] * s_, v[3][c] * s_); w.y = cvt4_fp8(v[4][c] * s_, v[5][c] * s_, v[6][c] * s_, v[7][c] * s_);
                w.z = cvt4_fp8(v[8][c] * s_, v[9][c] * s_, v[10][c] * s_, v[11][c] * s_); w.w = cvt4_fp8(v[12][c] * s_, v[13][c] * s_, v[14][c] * s_, v[15][c] * s_);
                *(LAS u32x4*)(lds + (4 * lane + c) * 128 + ((wave ^ sw) << 4)) = w; }
        } else {
#pragma unroll
            for (int c = 0; c < 4; ++c) { u32x4 w0, w1;
                w0.x = cvt_pk_bf16(v[0][c], v[1][c]); w0.y = cvt_pk_bf16(v[2][c], v[3][c]); w0.z = cvt_pk_bf16(v[4][c], v[5][c]); w0.w = cvt_pk_bf16(v[6][c], v[7][c]);
                w1.x = cvt_pk_bf16(v[8][c], v[9][c]); w1.y = cvt_pk_bf16(v[10][c], v[11][c]); w1.z = cvt_pk_bf16(v[12][c], v[13][c]); w1.w = cvt_pk_bf16(v[14][c], v[15][c]);
                *(LAS u32x4*)(lds + (4 * lane + c) * 256 + (((2 * wave) ^ sw) << 4)) = w0; *(LAS u32x4*)(lds + (4 * lane + c) * 256 + (((2 * wave + 1) ^ sw) << 4)) = w1; }
        }
        const TD done = cur; ++j;
        const bool more = (first + j * step < nitems) && !(POLL && flag[0] != 0u);
        if (more) { cur = tr_get(P, base + first + j * step, lane, wave); TR_LOAD(cur); }
        __syncthreads();
        if (done.fp8) {
#pragma unroll
            for (int q = 0; q < 4; ++q) { const int id = tid + 512 * q, n = id >> 3, ch = id & 7; const u32x4 w = *(const LAS u32x4*)(lds + n * 128 + ((ch ^ ((n >> 2) & 7)) << 4));
                *(u32x4*)(done.dst + (size_t)n * done.dpitch + ch * 16) = w; }
        } else {
#pragma unroll
            for (int q = 0; q < 8; ++q) { const int id = tid + 512 * q, n = id >> 4, ch = id & 15; const u32x4 w = *(const LAS u32x4*)(lds + n * 256 + ((ch ^ ((n >> 2) & 7)) << 4));
                *(u32x4*)(done.dst + (size_t)n * done.dpitch + ch * 16) = w; }
        }
        if (POLL && tid == 0) flag[0] = (pollv >= target) ? 1u : 0u;
        __syncthreads();
        if (!more) break;
    }
#undef TR_LOAD
    return j;
}

__device__ __forceinline__ void tr_amax(const Ctx& P, LAS unsigned char* lds, int base, int first, int step, int nN) {
    const int tid = threadIdx.x, lane = tid & 63, wave = __builtin_amdgcn_readfirstlane(tid >> 6);
    LAS float* red = (LAS float*)lds;
    for (int js = first; js < 2 * nN; js += step) { const int it = (js >= nN) ? js - nN + 8 * nN : js;
        const TD t = tr_get(P, base + it, lane, wave); f32x4 mx = (f32x4){0.f, 0.f, 0.f, 0.f};
        if (t.p) {
#pragma unroll
            for (int i = 0; i < 16; ++i) { const f32x4 v = *(const f32x4*)(t.p + (size_t)i * t.ld); mx[0] = fmaxf(mx[0], fabsf(v[0])); mx[1] = fmaxf(mx[1], fabsf(v[1])); mx[2] = fmaxf(mx[2], fabsf(v[2])); mx[3] = fmaxf(mx[3], fabsf(v[3])); } }
        *(LAS f32x4*)(red + wave * 256 + 4 * lane) = mx;
        __syncthreads();
        if (tid < 256) { float m = red[tid];
#pragma unroll
            for (int w = 1; w < 8; ++w) m = fmaxf(m, red[w * 256 + tid]);
            atomicMax((unsigned*)(t.cm - 4 * lane + tid), __float_as_uint(m * 1.3f)); }
        __syncthreads();
    }
}
__device__ __forceinline__ void tr_slack(const Ctx& P, LAS unsigned char* lds, unsigned* tilectr, unsigned* cnt, unsigned target) {
    const int tid = threadIdx.x, lane = tid & 63, wave = __builtin_amdgcn_readfirstlane(tid >> 6);
    volatile LAS int* box = (volatile LAS int*)(lds + LDS_MISC + 2048);
    int r = -1; unsigned pollv = 0u;
    if (tid == 0) { int stop0 = 0; if (cnt) stop0 = (__hip_atomic_load(cnt, __ATOMIC_RELAXED, __HIP_MEMORY_SCOPE_AGENT) >= target) ? 1 : 0;
        box[0] = stop0 ? -1 : (int)__hip_atomic_fetch_add(tilectr, 1u, __ATOMIC_RELAXED, __HIP_MEMORY_SCOPE_AGENT); box[1] = stop0; }
    __syncthreads();
    int idx = box[0], stop = box[1];
    const int sw = lane & 7;
    while (idx >= 0 && idx < TR_NMOE) {
        const TD cur = tr_get(P, TR_NMAIN + idx, lane, wave);
        f32x4 v[16];
#pragma unroll
        for (int i = 0; i < 16; ++i) v[i] = __builtin_nontemporal_load((const f32x4*)(cur.p + (size_t)i * cur.ld));
        if (tid == 0 && !stop) { r = (int)__hip_atomic_fetch_add(tilectr, 1u, __ATOMIC_RELAXED, __HIP_MEMORY_SCOPE_AGENT); if (cnt) pollv = __hip_atomic_load(cnt, __ATOMIC_RELAXED, __HIP_MEMORY_SCOPE_AGENT); }
        if (cur.fp8 == 2) {
            const f32x4 cm4 = *(const f32x4*)cur.cm;
#pragma unroll
            for (int c = 0; c < 4; ++c) { u32x4 w; const float s_ = 127.0f / cm4[c];
                w.x = cvt4_i8(v[0][c] * s_, v[1][c] * s_, v[2][c] * s_, v[3][c] * s_); w.y = cvt4_i8(v[4][c] * s_, v[5][c] * s_, v[6][c] * s_, v[7][c] * s_);
                w.z = cvt4_i8(v[8][c] * s_, v[9][c] * s_, v[10][c] * s_, v[11][c] * s_); w.w = cvt4_i8(v[12][c] * s_, v[13][c] * s_, v[14][c] * s_, v[15][c] * s_);
                *(LAS u32x4*)(lds + (4 * lane + c) * 128 + ((wave ^ sw) << 4)) = w; }
        } else {
#pragma unroll
        for (int c = 0; c < 4; ++c) { u32x4 w; const float s_ = cur.wscale;
            w.x = cvt4_fp8(v[0][c] * s_, v[1][c] * s_, v[2][c] * s_, v[3][c] * s_); w.y = cvt4_fp8(v[4][c] * s_, v[5][c] * s_, v[6][c] * s_, v[7][c] * s_);
            w.z = cvt4_fp8(v[8][c] * s_, v[9][c] * s_, v[10][c] * s_, v[11][c] * s_); w.w = cvt4_fp8(v[12][c] * s_, v[13][c] * s_, v[14][c] * s_, v[15][c] * s_);
            *(LAS u32x4*)(lds + (4 * lane + c) * 128 + ((wave ^ sw) << 4)) = w; } }
        __syncthreads();
#pragma unroll
        for (int q = 0; q < 4; ++q) { const int id = tid + 512 * q, n = id >> 3, ch = id & 7; const u32x4 w = *(const LAS u32x4*)(lds + n * 128 + ((ch ^ ((n >> 2) & 7)) << 4));
            __builtin_nontemporal_store(w, (u32x4*)(cur.dst + (size_t)n * cur.dpitch + ch * 16)); }
        if (tid == 0) { box[0] = stop ? -1 : r; box[1] = stop ? 1 : ((cnt && pollv >= target) ? 1 : 0); }
        __syncthreads();
        idx = box[0]; stop = box[1];
    }
    __syncthreads();
}
template <int MODE>
__device__ __forceinline__ void phase_prologue(const Ctx& P, LAS unsigned char* lds, int vcu, int G) {
    const int tid = threadIdx.x, lane = tid & 63, wave = __builtin_amdgcn_readfirstlane(tid >> 6);
    unsigned char* ws = P.ws;
    auto fold_pool = [&]() { const int gw = vcu * 8 + wave, NGW = G * 8;
    LAS float* pwl = (LAS float*)(lds + wave * 8192);
    __syncthreads();
    for (int it = gw; it < 32 * 4 * 32; it += NGW) {
        const int nb = it & 31, g = (it >> 5) & 3, cblk = it >> 7; const int n = nb * 64 + lane, c0 = cblk * 8;
        const float* wo = P.in[15] + (size_t)(g * 256) * DM + n; const float* pw = P.in[9] + ((size_t)g * 256 + c0) * 256; const float* scl = P.in[10] + g * 256;
        { const f32x4 s4 = *(const f32x4*)(scl + 4 * lane);
#pragma unroll
          for (int q = 0; q < 8; ++q) *(LAS f32x4*)(pwl + q * 256 + 4 * lane) = *(const f32x4*)(pw + q * 256 + 4 * lane) * s4; }
        asm volatile("s_waitcnt lgkmcnt(0)" ::: "memory");
        float a[8];
#pragma unroll
        for (int cc = 0; cc < 8; ++cc) a[cc] = 0.f;
#pragma unroll 4
        for (int d4 = 0; d4 < 64; ++d4) { const f32x4 wv = (f32x4){wo[(size_t)(4 * d4) * DM], wo[(size_t)(4 * d4 + 1) * DM], wo[(size_t)(4 * d4 + 2) * DM], wo[(size_t)(4 * d4 + 3) * DM]};
#pragma unroll
            for (int cc = 0; cc < 8; ++cc) { const f32x4 p4 = *(const LAS f32x4*)(pwl + cc * 256 + 4 * d4); a[cc] += (p4[0] * wv[0] + p4[1] * wv[1]) + (p4[2] * wv[2] + p4[3] * wv[3]); } }
        u32x4 w; w.x = cvt_pk_bf16(a[0], a[1]); w.y = cvt_pk_bf16(a[2], a[3]); w.z = cvt_pk_bf16(a[4], a[5]); w.w = cvt_pk_bf16(a[6], a[7]);
        *(u32x4*)((bf16_t*)(ws + WS_WEOUT) + (size_t)n * DM + g * 256 + c0) = w;
        asm volatile("s_waitcnt lgkmcnt(0)" ::: "memory");
    }
    __syncthreads();
    };
    if constexpr (MODE == 0) {
    {
        LAS float* sS = (LAS float*)lds;
        LAS float* red = (LAS float*)(lds + 65536);
        for (int i = tid; i < 5 * DM; i += 512) { const int r = i / DM, k = i % DM; const float cv = r < 4 ? P.in[1][r * DM + k] : P.in[3][k]; sS[i] = siluf_(cv); }
        __syncthreads();
        for (int blk = vcu; blk < 256; blk += G) {
            const int layer = blk >> 7, cb = (blk & 127) * 96;
            const float* W = P.in[4] + (size_t)layer * DM * NMOD;
            const int cg = lane & 31, ks = lane >> 5; const bool act = cg < 24;
            f32x4 a[5];
#pragma unroll
            for (int r = 0; r < 5; ++r) a[r] = (f32x4){0.f, 0.f, 0.f, 0.f};
            if (act) {
                const float* wp = W + (size_t)(wave * 256 + ks) * NMOD + cb + 4 * cg;
#pragma unroll 8
                for (int i = 0; i < 128; ++i) { const f32x4 w = __builtin_nontemporal_load((const f32x4*)(wp + (size_t)(2 * i) * NMOD)); const int k = wave * 256 + 2 * i + ks;
#pragma unroll
                    for (int r = 0; r < 5; ++r) a[r] += w * sS[r * DM + k]; }
            }
#pragma unroll
            for (int r = 0; r < 5; ++r)
#pragma unroll
                for (int j = 0; j < 4; ++j) a[r][j] += __shfl_xor(a[r][j], 32);
            if (act && ks == 0) {
#pragma unroll
                for (int r = 0; r < 5; ++r)
#pragma unroll
                    for (int j = 0; j < 4; ++j) red[(wave * 5 + r) * 96 + 4 * cg + j] = a[r][j]; }
            __syncthreads();
            if (tid < 480) { const int r = tid / 96, cc = tid % 96; float s = 0.f;
#pragma unroll
                for (int w = 0; w < 8; ++w) s += red[(w * 5 + r) * 96 + cc];
                ((float*)(ws + WS_MOD))[((size_t)layer * 5 + r) * NMOD + cb + cc] = s + P.in[5][(size_t)layer * NMOD + cb + cc]; }
            __syncthreads();
        }
    }
    const int gw = vcu * 8 + wave, NGW = G * 8;
    if (gw == 0) { for (int i = lane; i < 1024; i += 64) { const int pos = i >> 4, f = i & 15; const float inv = exp2f(-(float)f * (13.287712379549449f / 16.0f)); float s, c; sincosf((float)pos * inv, &s, &c);
        ((float*)(ws + WS_ROPE))[2 * i] = c; ((float*)(ws + WS_ROPE))[2 * i + 1] = s; } }
    for (int i = gw * 64 + lane; i < 8 * 128 * 128 / 4; i += NGW * 64) { const f32x4 v = *(const f32x4*)(P.in[26] + 4 * (size_t)i); u32x2 w; w.x = cvt_pk_bf16(v[0], v[1]); w.y = cvt_pk_bf16(v[2], v[3]); *(u32x2*)(ws + WS_WSGU + 8 * (size_t)i) = w; }
    if (!(vcu & 1)) fold_pool();
    }
#ifndef PROBE_NWG
#define PROBE_NWG 128
#endif
    if (MODE == 1 && (int)blockIdx.x >= PROBE_NWG) return;
    const int f0 = MODE == 0 ? vcu : (int)blockIdx.x, st = MODE == 0 ? G : PROBE_NWG;
    const int f1 = MODE == 0 ? (vcu + G - 64 % G) % G : f0, f2 = MODE == 0 ? (vcu + 2 * G - (64 + 352) % G) % G : f0;
    (void)tr_run<false>(P, lds, TR_I0, f0, st, 0, TR_I1, nullptr, 0u);
    (void)tr_run<false>(P, lds, TR_I0 + TR_I1 + TR_I2, f1, st, 0, TR_I3, nullptr, 0u);
    (void)tr_run<false>(P, lds, TR_I0 + TR_I1 + TR_I2 + TR_I3 + TR_I4, f2, st, 0, TR_I5 + TR_I6 + TR_I7, nullptr, 0u);
    if constexpr (MODE == 0) {
        tr_amax(P, lds, 0, (vcu + 3 * G - 600 % G) % G, G, 12);
        tr_amax(P, lds, TR_I0 + TR_I1, (vcu + 3 * G - 624 % G) % G, G, 44);
        tr_amax(P, lds, TR_I0 + TR_I1 + TR_I2 + TR_I3, (vcu + 3 * G - 712 % G) % G, G, 13);
        { const int wave_g = vcu * 8 + wave;
          for (int rr = wave_g; rr < 16 * 32; rr += G * 8) { const int tsr = rr >> 5, e = tsr >> 1, half = tsr & 1, kr = (rr & 31) * 64 + 29;
              const float* src = (half ? P.in[32] : P.in[31]) + (size_t)e * DM * DFFE + (size_t)kr * DFFE; float m = 0.f;
#pragma unroll 7
              for (int c = lane * 4; c < DFFE; c += 256) { const f32x4 v4 = __builtin_nontemporal_load((const f32x4*)(src + c)); m = fmaxf(m, fmaxf(fmaxf(fabsf(v4[0]), fabsf(v4[1])), fmaxf(fabsf(v4[2]), fabsf(v4[3])))); }
#pragma unroll
              for (int o = 1; o < 64; o <<= 1) m = fmaxf(m, __shfl_xor(m, o));
              if (lane == 0) atomicMax((unsigned*)(P.ws + WS_CTL) + CW_MOEMAX + tsr, __float_as_uint(m)); } }
        if (vcu & 1) fold_pool();
    }
}

template <int SRC, int CTXP = 0, bool OUTI8 = false>
__device__ __forceinline__ void phase_norm(const Ctx& P, int layer, int nrows, const float* gvec, int shc, int scc, int vcu, int G) {
    const int tid = threadIdx.x, lane = tid & 63, wave = __builtin_amdgcn_readfirstlane(tid >> 6);
    const int gw = vcu * 8 + wave, NGW = G * 8;
    const float* mod = (const float*)(P.ws + WS_MOD) + (size_t)layer * 5 * NMOD;
    bf16_t* HN = (bf16_t*)(P.ws + WS_HN);
    for (int row = gw; row < nrows; row += NGW) {
        const float* xr = row < ML ? P.in[0] + (size_t)row * DM : P.in[2] + (size_t)(row - ML) * DM;
        const bf16_t* xb = (const bf16_t*)(P.ws + WS_XA) + (size_t)row * DM;
        const int cnd = cond_of(row);
        f32x4 v[8]; float ss = 0.f;
#pragma unroll
        for (int j = 0; j < 8; ++j) v[j] = (SRC == 0) ? *(const f32x4*)(xr + 4 * lane + 256 * j) : ld4_bf(xb + 4 * lane + 256 * j);
        if (CTXP != 0 && row >= ML) {
            const float* pp = (const float*)(P.ws + WS_PART) + (size_t)(row - ML) * DM; const float* xc = P.in[2] + (size_t)(row - ML) * DM;
#pragma unroll
            for (int j = 0; j < 8; ++j) { const int c = 4 * lane + 256 * j; if (CTXP == 1) v[j] = *(const f32x4*)(xc + c);
#pragma unroll
                for (int p = 0; p < (CTXP == 1 ? 4 : 2); ++p) v[j] += *(const f32x4*)(pp + (size_t)p * MC * DM + c);
                if (CTXP == 1) st4_bf((bf16_t*)(P.ws + WS_XA) + (size_t)row * DM + c, v[j]); }
        }
#pragma unroll
        for (int j = 0; j < 8; ++j) ss += sq4(v[j]);
        ss = wave_sum(ss); const float rstd = __builtin_amdgcn_rsqf(ss * (1.0f / DM) + EPS);
        const float* shp = mod + (size_t)cnd * NMOD + shc * DM; const float* scp = mod + (size_t)cnd * NMOD + scc * DM;
        if constexpr (OUTI8) {
            float amax = 0.f;
#pragma unroll
            for (int j = 0; j < 8; ++j) { const int c = 4 * lane + 256 * j; const f32x4 g4 = *(const f32x4*)(gvec + c), sc4 = *(const f32x4*)(scp + c), sh4 = *(const f32x4*)(shp + c);
                v[j] = v[j] * rstd * g4 * (sc4 + 1.0f) + sh4; amax = fmaxf(amax, fmaxf(fmaxf(fabsf(v[j][0]), fabsf(v[j][1])), fmaxf(fabsf(v[j][2]), fabsf(v[j][3])))); }
#pragma unroll
            for (int o = 1; o < 64; o <<= 1) amax = fmaxf(amax, __shfl_xor(amax, o));
            amax = fmaxf(amax, 1e-30f); const float qs = 127.0f / amax;
            if (lane == 0) ((float*)(P.ws + WS_RSC))[row] = amax * (1.0f / 127.0f);
#pragma unroll
            for (int j = 0; j < 8; ++j) *(unsigned*)((unsigned char*)HN + (size_t)row * DM + 4 * lane + 256 * j) = cvt4_i8(v[j][0] * qs, v[j][1] * qs, v[j][2] * qs, v[j][3] * qs);
        } else {
#pragma unroll
        for (int j = 0; j < 8; ++j) { const int c = 4 * lane + 256 * j; const f32x4 g4 = *(const f32x4*)(gvec + c), sc4 = *(const f32x4*)(scp + c), sh4 = *(const f32x4*)(shp + c);
            const f32x4 h = v[j] * rstd * g4 * (sc4 + 1.0f) + sh4; u32x2 w; w.x = cvt_pk_bf16(h[0], h[1]); w.y = cvt_pk_bf16(h[2], h[3]);
            *(u32x2*)(HN + (size_t)row * DM + c) = w; }
        }
    }
}

template <int W>
__device__ __forceinline__ void pool_tile(const bf16_t* __restrict__ U, bf16_t* __restrict__ Y0, int rowbase, int L, int t0, int c0) {
    f32x2 uu[32 + W - 1];
#pragma unroll
    for (int q = 0; q < 32 + W - 1; ++q) { const int j = t0 - W / 2 + q; unsigned w = 0u; if (j >= 0 && j < L) w = *(const unsigned*)(U + (size_t)(rowbase + j) * 1024 + c0); uu[q] = (f32x2){bf_lo(w), bf_hi(w)}; }
#pragma unroll
    for (int tt = 0; tt < 32; ++tt) { f32x2 s = uu[tt];
#pragma unroll
        for (int q = 1; q < W; ++q) s += uu[tt + q];
        const int t = t0 + tt; const int lo = t - W / 2 < 0 ? 0 : t - W / 2; const int hi = t - W / 2 + W > L ? L : t - W / 2 + W;
        const float inv = 1.0f / (float)(hi - lo); const f32x2 pl = s * inv - uu[tt + W / 2];
        *(unsigned*)(Y0 + (size_t)(rowbase + t) * DM + c0) = cvt_pk_bf16(pl[0], pl[1]); }
}
__device__ __forceinline__ void phase_convpool(const Ctx& P, LAS unsigned char* lds, int vcu, int G) {
    const int tid = threadIdx.x, lane = tid & 63, wave = __builtin_amdgcn_readfirstlane(tid >> 6);
    const bf16_t* U = (const bf16_t*)(P.ws + WS_U); const bf16_t* Z = (const bf16_t*)(P.ws + WS_Z); bf16_t* Y0 = (bf16_t*)(P.ws + WS_Y0);
    LAS float* tile = (LAS float*)lds;
    const int c0 = 2 * tid;
    f32x2 wk[31];
#pragma unroll
    for (int k = 0; k < 31; ++k) wk[k] = *(const f32x2*)(P.in[11] + (size_t)k * 1024 + c0);
    const f32x2 cb = *(const f32x2*)(P.in[12] + c0);
    constexpr int NU = 4 * 128 + 4 * 8;
    for (int un = vcu; un < NU; un += G) {
        int rowbase, L, t0;
        if (un < 512) { rowbase = (un >> 7) * SEQ; L = SEQ; t0 = (un & 127) * 32; } else { const int q = un - 512; rowbase = ML + (q >> 3) * CTXL; L = CTXL; t0 = (q & 7) * 32; }
        const int grp = wave >> 1;
        if (grp == 0) pool_tile<2>(U, Y0, rowbase, L, t0, c0); else if (grp == 1) pool_tile<4>(U, Y0, rowbase, L, t0, c0); else if (grp == 2) pool_tile<8>(U, Y0, rowbase, L, t0, c0); else pool_tile<16>(U, Y0, rowbase, L, t0, c0);
        {
            f32x2 zr[62];
#pragma unroll
            for (int q = 0; q < 62; ++q) { const int j = t0 - 15 + q; unsigned w = 0u; if (j >= 0 && j < L) w = *(const unsigned*)(Z + (size_t)(rowbase + j) * 1024 + c0); zr[q] = (f32x2){bf_lo(w), bf_hi(w)}; }
#pragma unroll
            for (int tt = 0; tt < 32; ++tt) { f32x2 a = cb;
#pragma unroll
                for (int k = 0; k < 31; ++k) a += wk[k] * zr[tt + k];
                *(LAS f32x2*)(tile + tt * 1024 + c0) = a; }
        }
        __syncthreads();
#pragma unroll
        for (int q = 0; q < 4; ++q) { const int tt = wave * 4 + q; f32x4 v[4]; float s = 0.f;
#pragma unroll
            for (int j = 0; j < 4; ++j) { v[j] = *(const LAS f32x4*)(tile + tt * 1024 + 4 * lane + 256 * j); s += sum4(v[j]); }
            const float mean = wave_sum(s) * (1.0f / 1024.0f); float s2 = 0.f;
#pragma unroll
            for (int j = 0; j < 4; ++j) { v[j] = v[j] - mean; s2 += sq4(v[j]); }
            const float rstd = __builtin_amdgcn_rsqf(wave_sum(s2) * (1.0f / 1024.0f) + EPS);
#pragma unroll
            for (int j = 0; j < 4; ++j) { const int c = 4 * lane + 256 * j; const f32x4 g4 = *(const f32x4*)(P.in[13] + c), b4 = *(const f32x4*)(P.in[14] + c); f32x4 y = v[j] * rstd * g4 + b4;
#pragma unroll
                for (int e = 0; e < 4; ++e) y[e] = siluf_(y[e]);
                u32x2 w; w.x = cvt_pk_bf16(y[0], y[1]); w.y = cvt_pk_bf16(y[2], y[3]); *(u32x2*)(Y0 + (size_t)(rowbase + t0 + tt) * DM + 1024 + c) = w; } }
        __syncthreads();
    }
}

__device__ __forceinline__ void phase_sgu(const Ctx& P, LAS unsigned char* lds, int vcu, int G) {
    const int tid = threadIdx.x, lane = tid & 63, wave = __builtin_amdgcn_readfirstlane(tid >> 6), fr = lane & 15, fq = lane >> 4;
    const bf16_t* GU = (const bf16_t*)(P.ws + WS_GU); const bf16_t* GV = (const bf16_t*)(P.ws + WS_GV); const bf16_t* WS_ = (const bf16_t*)(P.ws + WS_WSGU); bf16_t* CAT = (bf16_t*)(P.ws + WS_Y0);
    const float* zs1 = (const float*)(P.ws + WS_CTL) + CW_ZS1; const float* zs2 = (const float*)(P.ws + WS_CTL) + CW_ZS2;
    constexpr int VS = 272;
    for (int un = vcu; un < 4 * 32 * 8; un += G) {
        const int h = un & 7, ch = un >> 3; const int r0 = ch * 128;
#pragma unroll
        for (int q = 0; q < 4; ++q) { const int id = tid + 512 * q, j = id & 127, dc = (id >> 7) * 8; const int row = r0 + j;
            const float mean = zs1[row] * (1.0f / 1024.0f); const float var = zs2[row] * (1.0f / 1024.0f) - mean * mean; const float rstd = __builtin_amdgcn_rsqf(var + EPS);
            const u32x4 raw = *(const u32x4*)(GV + (size_t)row * 1024 + h * 128 + dc);
            const f32x4 g0 = *(const f32x4*)(P.in[24] + h * 128 + dc), g1 = *(const f32x4*)(P.in[24] + h * 128 + dc + 4), b0 = *(const f32x4*)(P.in[25] + h * 128 + dc), b1 = *(const f32x4*)(P.in[25] + h * 128 + dc + 4);
            const float x[8] = {bf_lo(raw.x), bf_hi(raw.x), bf_lo(raw.y), bf_hi(raw.y), bf_lo(raw.z), bf_hi(raw.z), bf_lo(raw.w), bf_hi(raw.w)};
            const float gg[8] = {g0[0], g0[1], g0[2], g0[3], g1[0], g1[1], g1[2], g1[3]}, bb[8] = {b0[0], b0[1], b0[2], b0[3], b1[0], b1[1], b1[2], b1[3]};
#pragma unroll
            for (int e = 0; e < 8; ++e) { const float y = (x[e] - mean) * rstd * gg[e] + bb[e]; *(LAS bf16_t*)(lds + (dc + e) * VS + j * 2) = (bf16_t)(cvt_pk_bf16(y, 0.f) & 0xffffu); } }
        __syncthreads();
        const int i0 = wave * 16;
        bf16x8 af[4];
#pragma unroll
        for (int kk = 0; kk < 4; ++kk) af[kk] = *(const bf16x8*)(WS_ + (size_t)(h * 128 + i0 + fr) * 128 + kk * 32 + fq * 8);
        const float bias = P.in[27][h * 128 + i0 + fr]; const int orow = r0 + i0 + fr;
#pragma unroll
        for (int nb = 0; nb < 8; ++nb) { f32x4 acc = (f32x4){0.f, 0.f, 0.f, 0.f};
#pragma unroll
            for (int kk = 0; kk < 4; ++kk) { const bf16x8 bfr = *(const LAS bf16x8*)(lds + (nb * 16 + fr) * VS + (kk * 32 + fq * 8) * 2); acc = __builtin_amdgcn_mfma_f32_16x16x32_bf16(bfr, af[kk], acc, 0, 0, 0); }
            const int d = nb * 16 + 4 * fq; const u32x2 gu = *(const u32x2*)(GU + (size_t)orow * 1024 + h * 128 + d);
            const float o0 = bf_lo(gu.x) * (acc[0] + bias), o1 = bf_hi(gu.x) * (acc[1] + bias), o2 = bf_lo(gu.y) * (acc[2] + bias), o3 = bf_hi(gu.y) * (acc[3] + bias);
            u32x2 w; w.x = cvt_pk_bf16(o0, o1); w.y = cvt_pk_bf16(o2, o3); *(u32x2*)(CAT + (size_t)orow * DM + 1024 + h * 128 + d) = w; }
        __syncthreads();
    }
}

__device__ __forceinline__ void phase_router(const Ctx& P, LAS unsigned char* lds, int vcu, int G) {
    const int tid = threadIdx.x, lane = tid & 63, wave = __builtin_amdgcn_readfirstlane(tid >> 6);
    LAS float* rwT = (LAS float*)lds;
    LAS unsigned char* rows8 = lds + 65536;
    LAS int* sel = (LAS int*)(lds + LDS_MISC + 1024);
    LAS float* prb = (LAS float*)(lds + LDS_MISC + 1024 + 256);
    LAS int* lrank = (LAS int*)(lds + LDS_MISC + 1024 + 512);
    LAS int* lcnt = (LAS int*)(lds + LDS_MISC + 1024 + 768);
    LAS int* lbase = (LAS int*)(lds + LDS_MISC + 1024 + 832);
    LAS float* rscl = (LAS float*)(lds + LDS_MISC + 1024 + 864);
    for (int i = tid; i < DM * 8; i += 512) { const int k = i >> 3, e = i & 7; rwT[e * DM + k] = P.in[29][i]; }
    __syncthreads();
    const float* mod = (const float*)(P.ws + WS_MOD) + (size_t)5 * NMOD;
    const float* gvec = P.in[7] + DM;
    unsigned char* HNP = P.ws + WS_HNP; unsigned* ecnt = (unsigned*)(P.ws + WS_CTL) + CW_ECNT; int* tok = (int*)(P.ws + WS_TOK);
    for (int blk = vcu; blk < ML / 32; blk += G) {
        if (tid < 8) lcnt[tid] = 0;
        for (int q = 0; q < 4; ++q) {
            const int lr = wave * 4 + q, row = blk * 32 + lr; const int cnd = row >> 12;
            const bf16_t* xr = (const bf16_t*)(P.ws + WS_XA) + (size_t)row * DM;
            f32x4 v[8]; float ss = 0.f;
#pragma unroll
            for (int j = 0; j < 8; ++j) { v[j] = ld4_bf(xr + 4 * lane + 256 * j); ss += sq4(v[j]); }
            ss = wave_sum(ss); const float rstd = __builtin_amdgcn_rsqf(ss * (1.0f / DM) + EPS);
            const float* shp = mod + (size_t)cnd * NMOD + 3 * DM; const float* scp = mod + (size_t)cnd * NMOD + 4 * DM;
            float lg[8]; float amax = 0.f;
#pragma unroll
            for (int e = 0; e < 8; ++e) lg[e] = 0.f;
#pragma unroll
            for (int j = 0; j < 8; ++j) { const int c = 4 * lane + 256 * j; const f32x4 g4 = *(const f32x4*)(gvec + c), sc4 = *(const f32x4*)(scp + c), sh4 = *(const f32x4*)(shp + c);
                const f32x4 h = v[j] * rstd * g4 * (sc4 + 1.0f) + sh4;
                amax = fmaxf(amax, fmaxf(fmaxf(fabsf(h[0]), fabsf(h[1])), fmaxf(fabsf(h[2]), fabsf(h[3]))));
#pragma unroll
                for (int e = 0; e < 8; ++e) { const f32x4 rw = *(const LAS f32x4*)(rwT + e * DM + c); lg[e] += (h[0] * rw[0] + h[1] * rw[1]) + (h[2] * rw[2] + h[3] * rw[3]); } }
#pragma unroll
            for (int e = 0; e < 8; ++e) lg[e] = wave_sum(lg[e]) + P.in[30][e];
#pragma unroll
            for (int o = 1; o < 64; o <<= 1) amax = fmaxf(amax, __shfl_xor(amax, o));
            amax = fmaxf(amax, 1e-30f);
            if (lane == 0) rscl[lr] = amax * (1.0f / 127.0f);
            { const float qs = 127.0f / amax; int l2 = lane; asm volatile("" : "+v"(l2));
#pragma unroll 2
              for (int j = 0; j < 8; ++j) { const int c = 4 * l2 + 256 * j; const f32x4 x4 = ld4_bf(xr + c), g4 = *(const f32x4*)(gvec + c), sc4 = *(const f32x4*)(scp + c), sh4 = *(const f32x4*)(shp + c);
                  const f32x4 h = (x4 * rstd * g4 * (sc4 + 1.0f) + sh4) * qs; *(LAS unsigned*)(rows8 + lr * DM + c) = cvt4_i8(h[0], h[1], h[2], h[3]); } }
            int i1 = 0; float v1 = lg[0];
#pragma unroll
            for (int e = 1; e < 8; ++e) if (lg[e] > v1) { v1 = lg[e]; i1 = e; }
            int i2 = -1; float v2 = -3.0e38f;
#pragma unroll
            for (int e = 0; e < 8; ++e) if (e != i1 && lg[e] > v2) { v2 = lg[e]; i2 = e; }
            const float p1 = 1.0f / (1.0f + __expf(v2 - v1));
            if (lane == 0) { sel[lr * 2] = i1; sel[lr * 2 + 1] = i2; prb[lr * 2] = p1; prb[lr * 2 + 1] = 1.0f - p1; }
        }
        __syncthreads();
        if (tid < 64) lrank[tid] = atomicAdd((int*)&lcnt[sel[tid]], 1);
        __syncthreads();
        if (tid < 8) lbase[tid] = (int)atomicAdd(ecnt + 64 * tid, (unsigned)lcnt[tid]);
        __syncthreads();
        if (tid < 64) { const int lr = tid >> 1, which = tid & 1, e = sel[tid], pos = lbase[e] + lrank[tid], row = blk * 32 + lr;
            tok[row * 8 + which * 2] = e; tok[row * 8 + which * 2 + 1] = pos; ((float*)tok)[row * 8 + 4 + which] = prb[tid]; }
#pragma unroll
        for (int q = 0; q < 4; ++q) { const int lr = wave * 4 + q; const u32x4 d0 = *(const LAS u32x4*)(rows8 + lr * DM + lane * 16), d1 = *(const LAS u32x4*)(rows8 + lr * DM + 1024 + lane * 16);
#pragma unroll
            for (int which = 0; which < 2; ++which) { const int e = sel[lr * 2 + which], pos = lbase[e] + lrank[lr * 2 + which]; unsigned char* dst = HNP + ((size_t)e * ML + pos) * DM;
                *(u32x4*)(dst + lane * 16) = d0; *(u32x4*)(dst + 1024 + lane * 16) = d1; if (lane == 0) ((float*)(P.ws + WS_MRS))[(size_t)e * ML + pos] = rscl[lr]; } }
        __syncthreads();
    }
}
__device__ __forceinline__ void moe_tables(const Ctx& P, volatile LAS int* tab, int nN) {
    if (tid_opaque() == 0) { const unsigned* ecnt = (const unsigned*)(P.ws + WS_CTL) + CW_ECNT; int pb = 0, cu = 0;
        for (int e = 0; e < 8; ++e) { const int c = (int)ecnt[64 * e], np = (c + 255) >> 8; tab[e] = c; tab[8 + e] = pb; tab[16 + e] = cu; pb += np; cu += np * nN; }
        tab[24] = cu; }
    __syncthreads();
}

__device__ __forceinline__ void phase_final(const Ctx& P, volatile LAS int* tab, int vcu, int G) {
    const int tid = threadIdx.x, lane = tid & 63, wave = __builtin_amdgcn_readfirstlane(tid >> 6);
    const int gw = vcu * 8 + wave, NGW = G * 8;
    const float* mod = (const float*)(P.ws + WS_MOD) + (size_t)5 * NMOD; const int* tok = (const int*)(P.ws + WS_TOK); const bf16_t* YB = (const bf16_t*)(P.ws + WS_YB);
    for (int row = gw; row < ML; row += NGW) {
        const int e1 = tok[row * 8], pos1 = tok[row * 8 + 1], e2 = tok[row * 8 + 2], pos2 = tok[row * 8 + 3]; const float p1 = ((const float*)tok)[row * 8 + 4], p2 = ((const float*)tok)[row * 8 + 5];
        const bf16_t* y1 = YB + (size_t)(tab[8 + e1] * 256 + pos1) * DM; const bf16_t* y2 = YB + (size_t)(tab[8 + e2] * 256 + pos2) * DM;
        const bf16_t* xr = (const bf16_t*)(P.ws + WS_XA) + (size_t)row * DM; const float* g2 = mod + (size_t)(row >> 12) * NMOD + 5 * DM;
        f32x4 v[8]; float ss = 0.f;
#pragma unroll
        for (int j = 0; j < 8; ++j) { const int c = 4 * lane + 256 * j; const f32x4 x4 = ld4_bf(xr + c), g4 = *(const f32x4*)(g2 + c); const u32x2 a = __builtin_nontemporal_load((const u32x2*)(y1 + c)), b = __builtin_nontemporal_load((const u32x2*)(y2 + c));
            const f32x4 ya = (f32x4){bf_lo(a.x), bf_hi(a.x), bf_lo(a.y), bf_hi(a.y)}, yb = (f32x4){bf_lo(b.x), bf_hi(b.x), bf_lo(b.y), bf_hi(b.y)};
            v[j] = x4 + g4 * (ya * p1 + yb * p2); ss += sq4(v[j]); }
        ss = wave_sum(ss); const float rstd = __builtin_amdgcn_rsqf(ss * (1.0f / DM) + EPS);
#pragma unroll
        for (int j = 0; j < 8; ++j) { const int c = 4 * lane + 256 * j; const f32x4 fg = *(const f32x4*)(P.in[34] + c); __builtin_nontemporal_store(v[j] * rstd * fg, (f32x4*)(P.out + (size_t)row * DM + c)); }
    }
}

__global__ void __launch_bounds__(512, 2) fwd_kernel(Params KP) {
    extern __shared__ __attribute__((aligned(16))) unsigned char lds_raw[];
    LAS unsigned char* lds = (LAS unsigned char*)lds_raw;
    volatile LAS unsigned* MISC = (volatile LAS unsigned*)(lds + LDS_MISC);
    volatile LAS int* tab = (volatile LAS int*)(lds + LDS_MISC + 256);
    const int G = KP.grid; const int bx = blockIdx.x; const int vcu = (G % 8 == 0) ? (bx % 8) * (G / 8) + bx / 8 : bx;
    unsigned char* ws = KP.ws;
    for (int u = threadIdx.x; u < (LDS_BYTES - LDS_MISC) / 4; u += 512) MISC[u] = 0u;
    __syncthreads();
    if (KP.use_bar && tid_opaque() == 0) (void)xb_add((unsigned*)(ws + WS_CTL) + CW_BAR + XB_XCNT(xb_xcc_id()), 1u);
#define KARG_I(member) (((const int*)in_tbl())[offsetof(Params, member) / 4])
#define MKCTX() const Ctx P{InTbl{in_tbl()}, (float*)*(__attribute__((address_space(1))) float* const*)((const char*)in_tbl() + offsetof(Params, out)), ws}
#ifndef PH_MASK
#define PH_MASK 0x1FFFF
#endif
#define IN(k) (((PH_MASK >> (k)) & 1) && KARG_I(ph_lo) <= (k) && (k) < KARG_I(ph_hi))
#define SEAM(k) do { if (IN(k) && IN((k) + 1)) { XcdBarrier bar_; bar_.bar = (unsigned*)(ws + WS_CTL) + CW_BAR; bar_.x = xb_xcc_id(); bar_.st = MISC + 8; bar_.G = (unsigned)KARG_I(grid); xcd_barrier(bar_); } } while (0)
    float* ctlf = (float*)(ws + WS_CTL);
#define SLACK(k) do { __syncthreads(); unsigned* dn_ = (unsigned*)(ws + WS_CTL) + CW_PHDONE + 64 * (k); if (tid_opaque() == 0) __hip_atomic_fetch_add(dn_, 1u, __ATOMIC_RELAXED, __HIP_MEMORY_SCOPE_AGENT); \
        tr_slack(P, lds, (unsigned*)(ws + WS_CTL) + CW_TILE, dn_, (unsigned)G); } while (0)
    const float* mod0 = (const float*)(ws + WS_MOD); const float* mod1 = mod0 + (size_t)5 * NMOD;

#ifndef PROBE_REP
#define PROBE_REP 0
#endif
#define REPS(k) (((PROBE_REP >> (k)) & 1) ? 2 : 1)
    if (IN(0)) { MKCTX(); phase_prologue<0>(P, lds, vcu, G); if (REPS(0) == 2) phase_prologue<1>(P, lds, vcu, G); } SEAM(0);
    if (IN(1)) { MKCTX();
        { const float* mm = (const float*)(ws + WS_CTL) + CW_MOEMAX; float* mcm = (float*)(ws + WS_MCM);
          for (int i = vcu * 512 + (int)threadIdx.x; i < NEXP * 14336; i += G * 512) { const int e = i / 14336, n = i - e * 14336; mcm[i] = fmaxf(mm[2 * e + ((n >> 7) & 1)] * 1.25f, 1e-30f); } }
        phase_norm<0, 0, true>(P, 0, MT, P.in[6], 0, 1, vcu, G);
        __syncthreads(); (void)tr_run<false>(P, lds, 0, vcu, G, 0, TR_I0, nullptr, 0u); (void)tr_run<false>(P, lds, TR_I0 + TR_I1, vcu, G, 0, TR_I2, nullptr, 0u);
        (void)tr_run<false>(P, lds, TR_I0 + TR_I1 + TR_I2 + TR_I3, vcu, G, 0, TR_I4, nullptr, 0u); } SEAM(1);
    if (IN(2)) { MKCTX();
        pg8::DenseSched S{(const char*)(ws + WS_WEIN), DM / 2, DM / 2, G, bx, MT / 256, 12, 0, 0, 0, 0, DM / 128, 1};
        pg8::EpiEIn E{(bf16_t*)(ws + WS_U), (bf16_t*)(ws + WS_Z), (const float*)(ws + WS_RSC), ctlf + CW_CMAX_EIN};
        pg8::gemm_phase<pg8::EpiEIn, pg8::DenseSched, 2>(lds, (const char*)(ws + WS_HN), DM / 2, S, E);
        SLACK(2);
    } SEAM(2);
    if (IN(3)) { MKCTX(); phase_convpool(P, lds, vcu, G); } SEAM(3);
    if (IN(4)) { MKCTX();
        { pg8::DenseSched S{(const char*)(ws + WS_WEOUT), DM, DM, G, bx, ML / 256, 8, 0, 0, 0, 0, DM / 64, 1};
          pg8::EpiResT<float> E{P.in[0], P.in[2], (bf16_t*)(ws + WS_XA), mod0 + 2 * DM, 1.0f};
          pg8::gemm_phase(lds, (const char*)(ws + WS_Y0), DM, S, E); }
        { pg8::DenseSched S{(const char*)(ws + WS_WEOUT), DM, DM, G, bx, 0, 0, MC / 256, 8, ML / 256, 0, DM / 64, 4};
          pg8::EpiPart E{(float*)(ws + WS_PART), mod0 + 2 * DM, 1.0f};
          pg8::gemm_phase(lds, (const char*)(ws + WS_Y0), DM, S, E); }
        SLACK(4);
    } SEAM(4);
    if (IN(5)) { MKCTX(); phase_norm<1, 1, true>(P, 0, MT, P.in[7], 3, 4, vcu, G); } SEAM(5);
    if (IN(6)) { MKCTX();
        pg8::DenseSched S{(const char*)(ws + WS_WF1), DM / 2, DM / 2, G, bx, MT / 256, 44, 0, 0, 0, 0, DM / 128, 1};
        pg8::EpiSwiGLUi8 E{(bf16_t*)(ws + WS_ACT0), DFF, (const float*)(ws + WS_RSC), ctlf + CW_CMAX, ACTS};
        pg8::gemm_phase<pg8::EpiSwiGLUi8, pg8::DenseSched, 2>(lds, (const char*)(ws + WS_HN), DM / 2, S, E);
        if (REPS(6) == 2) pg8::gemm_phase<pg8::EpiSwiGLUi8, pg8::DenseSched, 2>(lds, (const char*)(ws + WS_HN), DM / 2, S, E);
        SLACK(6);
    } SEAM(6);
    if (IN(7)) { MKCTX();
        { pg8::DenseSched S{(const char*)(ws + WS_WF2), DFF / 2, DFF / 2, G, bx, ML / 256, 8, 0, 0, 0, 0, DFF / 128, 1};
          pg8::EpiResT<bf16_t> E{(const bf16_t*)(ws + WS_XA), (const bf16_t*)(ws + WS_XA) + (size_t)ML * DM, (bf16_t*)(ws + WS_XA), mod0 + 5 * DM, 1.0f / (W2S * ACTS)};
          pg8::gemm_phase<pg8::EpiResT<bf16_t>, pg8::DenseSched, 1>(lds, (const char*)(ws + WS_ACT0), DFF / 2, S, E); }
        { pg8::DenseSched S{(const char*)(ws + WS_WF2), DFF / 2, DFF / 2, G, bx, 0, 0, MC / 256, 8, ML / 256, 0, DFF / 128, 2};
          pg8::EpiPart E{(float*)(ws + WS_PART), mod0 + 5 * DM, 1.0f / (W2S * ACTS)};
          pg8::gemm_phase<pg8::EpiPart, pg8::DenseSched, 1>(lds, (const char*)(ws + WS_ACT0), DFF / 2, S, E); }
        SLACK(7);
    } SEAM(7);
    if (IN(8)) { MKCTX(); phase_norm<1, 2, true>(P, 1, MT, P.in[6] + DM, 0, 1, vcu, G); } SEAM(8);
    if (IN(9)) { MKCTX();
        pg8::DenseSched S{(const char*)(ws + WS_WOIN), DM / 2, DM / 2, G, bx, ML / 256, 13, MC / 256, 3, ML / 256, 2, DM / 128, 1};
        pg8::EpiOIn E{(bf16_t*)(ws + WS_CQ), (bf16_t*)(ws + WS_CKV), (bf16_t*)(ws + WS_GU), (bf16_t*)(ws + WS_GV), ws + WS_K, ctlf + CW_SSQQ, ctlf + CW_SSQKV, ctlf + CW_ZS1, ctlf + CW_ZS2, (const float*)(ws + WS_ROPE), (const float*)(ws + WS_RSC), ctlf + CW_CMAX_OIN};
        pg8::gemm_phase<pg8::EpiOIn, pg8::DenseSched, 2>(lds, (const char*)(ws + WS_HN), DM / 2, S, E);
        SLACK(9);
    } SEAM(9);
    if (IN(10)) { MKCTX();
        { pg8::QKVSched S{(const char*)(ws + WS_WQB), (const char*)(ws + WS_WKVB), (unsigned)(WS_CKV - WS_CQ), 512, 512, G, bx};
          pg8::EpiQKV E{pg8::EpiQ{ws + WS_Q, ctlf + CW_SSQQ, (const float*)(ws + WS_ROPE)}, pg8::EpiKV{ws + WS_K, ws + WS_V, ctlf + CW_SSQKV}};
          pg8::gemm_phase(lds, (const char*)(ws + WS_CQ), 512, S, E); }
        phase_sgu(P, lds, vcu, G);
        SLACK(10);
    } SEAM(10);
    if (IN(11)) { MKCTX();
        const unsigned char* Qb = ws + WS_Q; const unsigned char* Kb = ws + WS_K; const unsigned char* Vb = ws + WS_V; bf16_t* CAT = (bf16_t*)(ws + WS_Y0);
        for (int rp = 0; rp < REPS(11); ++rp)
        for (int un = vcu; un < NB * 8 * 16; un += G) {
            const int qb = un & 15, bh = un >> 4, h = bh & 7, b = bh >> 3;
            __syncthreads();
            att::attn_body(Qb + ((size_t)(b * SEQ + qb * 256) * 1536 + h * 192), Kb + ((size_t)b * KVL * 1536 + h * 192), Vb + (size_t)(b * 8 + h) * 128 * KVL,
                           CAT + ((size_t)(b * SEQ + qb * 256) * DM + h * 128), KVL, (char*)lds_raw);
        }
    } SEAM(11);
    if (IN(12)) { MKCTX();
        pg8::DenseSched S{(const char*)(ws + WS_WOOUT), DM, DM, G, bx, ML / 256, 8, 0, 0, 0, 0, DM / 64, 1};
        pg8::EpiResT<bf16_t> E{(const bf16_t*)(ws + WS_XA), (const bf16_t*)(ws + WS_XA) + (size_t)ML * DM, (bf16_t*)(ws + WS_XA), mod1 + 2 * DM, 1.0f};
        pg8::gemm_phase(lds, (const char*)(ws + WS_Y0), DM, S, E);
    } SEAM(12);
    if (IN(13)) { MKCTX();
        if (vcu & 1) { phase_router(P, lds, vcu, G); __syncthreads(); tr_slack(P, lds, (unsigned*)(ws + WS_CTL) + CW_TILE, nullptr, 0u); }
        else { tr_slack(P, lds, (unsigned*)(ws + WS_CTL) + CW_TILE, nullptr, 0u); __syncthreads(); phase_router(P, lds, vcu, G); } } SEAM(13);
    if (IN(14)) { MKCTX();
        moe_tables(P, tab, 56);
        pg8::MoeSched S{(const char*)(ws + WS_WM1), (const int*)(ws + WS_LIST), tab, DM / 2, DM / 2, G, bx, 56, 1, (size_t)14336 * DM, DM / 128};
        pg8::EpiSwiGLUi8M E{ws + WS_ACT1, DFFE, (const float*)(ws + WS_MRS), (const float*)(ws + WS_MCM), ACTS};
        pg8::gemm_phase<pg8::EpiSwiGLUi8M, pg8::MoeSched, 2>(lds, (const char*)(ws + WS_HNP), DM / 2, S, E);
        if (REPS(14) == 2) pg8::gemm_phase<pg8::EpiSwiGLUi8M, pg8::MoeSched, 2>(lds, (const char*)(ws + WS_HNP), DM / 2, S, E);
    } SEAM(14);
    if (IN(15)) { MKCTX();
        moe_tables(P, tab, 8);
        pg8::MoeSched S{(const char*)(ws + WS_WM2), (const int*)(ws + WS_LIST), tab, DFFE / 2, DFFE / 2, G, bx, 8, 0, (size_t)DM * DFFE, DFFE / 128};
        pg8::EpiBf16 E{(bf16_t*)(ws + WS_YB), DM, 1.0f / (W2S * ACTS)};
        pg8::gemm_phase<pg8::EpiBf16, pg8::MoeSched, 1>(lds, (const char*)(ws + WS_ACT1), DFFE / 2, S, E);
        if (REPS(15) == 2) pg8::gemm_phase<pg8::EpiBf16, pg8::MoeSched, 1>(lds, (const char*)(ws + WS_ACT1), DFFE / 2, S, E);
    } SEAM(15);
    if (IN(16)) { MKCTX(); moe_tables(P, tab, 8); phase_final(P, tab, vcu, G); }
#undef IN
#undef SEAM
}

#ifndef MK_PER_PHASE
#define MK_PER_PHASE 0
#endif
extern "C" void kernel_launch(void* const* d_in, const int* in_sizes, int n_in, void* d_out, int out_size, void* d_ws, size_t ws_size, hipStream_t stream) {
    static int grid = 0;
    if (grid == 0) {
        if (n_in != 35 || out_size != ML * DM || ws_size < WS_END) { fprintf(stderr, "kernel_launch: unexpected shapes: n_in %d out %d ws %zu (need %zu)\n", n_in, out_size, ws_size, (size_t)WS_END); grid = -1; return; }
        int dev = 0, cus = 0, per_cu = 0;
        if (hipGetDevice(&dev) != hipSuccess || hipDeviceGetAttribute(&cus, hipDeviceAttributeMultiprocessorCount, dev) != hipSuccess) { grid = -1; return; }
        if (hipFuncSetAttribute((const void*)fwd_kernel, hipFuncAttributeMaxDynamicSharedMemorySize, LDS_BYTES) != hipSuccess) { fprintf(stderr, "kernel_launch: hipFuncSetAttribute failed\n"); grid = -1; return; }
        if (hipOccupancyMaxActiveBlocksPerMultiprocessor(&per_cu, (const void*)fwd_kernel, 512, LDS_BYTES) != hipSuccess || per_cu < 1) fprintf(stderr, "kernel_launch: occupancy query says %d\n", per_cu);
        (void)hipGetLastError();
        grid = cus;
    }
    if (grid < 0) return;
    (void)hipMemsetAsync((char*)d_ws + WS_CTL, 0, CTL_BYTES, stream);
    Params p; memset(&p, 0, sizeof(p));
    for (int i = 0; i < 35; ++i) p.in[i] = (const float*)d_in[i];
    p.out = (float*)d_out; p.ws = (unsigned char*)d_ws; p.grid = grid;
#if MK_PER_PHASE
    for (int k = 0; k < NPHASE; ++k) { p.ph_lo = k; p.ph_hi = k + 1; p.use_bar = 0; hipLaunchKernelGGL(fwd_kernel, dim3(grid), dim3(512), LDS_BYTES, stream, p); }
#else
    p.ph_lo = 0; p.ph_hi = NPHASE; p.use_bar = 1;
    hipLaunchKernelGGL(fwd_kernel, dim3(grid), dim3(512), LDS_BYTES, stream, p);
#endif
    const hipError_t le = hipPeekAtLastError();
    if (le != hipSuccess) fprintf(stderr, "kernel_launch: launch failed: %s\n", hipGetErrorName(le));
}
```

```cpp
#include <hip/hip_runtime.h>
#include <cstdio>
#include <cstdint>
#include <cstring>
#include <cstddef>

#define LAS __attribute__((address_space(3)))
typedef unsigned short bf16_t;
typedef short bf16x8 __attribute__((ext_vector_type(8)));
typedef short s16x4 __attribute__((ext_vector_type(4)));
typedef float f32x2 __attribute__((ext_vector_type(2)));
typedef float f32x4 __attribute__((ext_vector_type(4)));
typedef float f32x16 __attribute__((ext_vector_type(16)));
typedef unsigned u32x2 __attribute__((ext_vector_type(2)));
typedef unsigned u32x4 __attribute__((ext_vector_type(4)));

constexpr int DM = 2048, NB = 4, SEQ = 4096, CTXL = 256;
constexpr int ML = NB * SEQ;
constexpr int MC = NB * CTXL;
constexpr int MT = ML + MC;
constexpr int DFF = 5632, DFFE = 7168, NEXP = 8;
constexpr int KVL = CTXL + SEQ;
constexpr int NMOD = 6 * DM;
constexpr float EPS = 1e-6f;
constexpr int MOE_ROWS = 2 * ML + NEXP * 256;
constexpr float W1S = 64.0f, W2S = 128.0f, ACTS = 4.0f;
constexpr float Q8S = 1.0f;
constexpr float QSCALE = 0.07216878364870322f * 1.4426950408889634f;

constexpr size_t al256(size_t x) { return (x + 255) & ~(size_t)255; }
constexpr size_t WS_CTL = 0, CTL_BYTES = 1u << 20;
constexpr int CW_BAR = 0;
constexpr int CW_ECNT = 4096;
constexpr int CW_TILE = 8192;
constexpr int CW_PHDONE = 8256;
constexpr int CW_SSQQ = 16384;
constexpr int CW_SSQKV = 32768;
constexpr int CW_ZS1 = 65536;
constexpr int CW_ZS2 = 81920;
constexpr int CW_CMAX_EIN = 109568;
constexpr int CW_CMAX_OIN = 112640;
constexpr int CW_CMAX = 98304;
constexpr size_t WS_MOD = 1u << 20;
constexpr size_t WS_ROPE = WS_MOD + (512u << 10);
constexpr size_t WS_TOK = 2u << 20;
constexpr size_t WS_LIST = WS_TOK + (512u << 10);
constexpr size_t WS_RSC = 3u << 20;
constexpr size_t WS_W0 = 4u << 20;
constexpr size_t WS_WEIN = WS_W0;
constexpr size_t WS_WEOUT = WS_WEIN + (size_t)3072 * 2048 * 2;
constexpr size_t WS_WF1 = WS_WEOUT + (size_t)2048 * 2048 * 2;
constexpr size_t WS_WF2 = WS_WF1 + (size_t)11264 * 2048 * 2;
constexpr size_t WS_WOIN = WS_WF2 + (size_t)2048 * 5632 * 2;
constexpr size_t WS_WQB = WS_WOIN + (size_t)3328 * 2048 * 2;
constexpr size_t WS_WKVB = WS_WQB + (size_t)1536 * 512 * 2;
constexpr size_t WS_WSGU = WS_WKVB + (size_t)2048 * 512 * 2;
constexpr size_t WS_WOOUT = WS_WSGU + (size_t)8 * 128 * 128 * 2;
constexpr size_t WS_WM1 = WS_WOOUT + (size_t)2048 * 2048 * 2;
constexpr size_t WS_WM2 = WS_WM1 + (size_t)8 * 14336 * 2048;
constexpr size_t WS_XA = al256(WS_WM2 + (size_t)8 * 2048 * 7168);
constexpr size_t WS_HN = WS_XA + (size_t)MT * DM * 4;
constexpr size_t WS_Y0 = WS_HN + (size_t)MT * DM * 2;
constexpr size_t WS_YB = WS_HN;
constexpr size_t WS_AR = WS_Y0 + (size_t)MT * DM * 2;
constexpr size_t AR_BYTES = (size_t)MOE_ROWS * DFFE * 2;
constexpr size_t WS_ACT0 = WS_AR;
constexpr size_t WS_U = WS_ACT0 + (size_t)MT * DFF * 2;
constexpr size_t WS_Z = WS_U + (size_t)MT * 1024 * 2;
constexpr size_t WS_CQ = WS_AR;
constexpr size_t WS_CKV = WS_CQ + (size_t)ML * 512 * 2;
constexpr size_t WS_GU = WS_CKV + (size_t)MT * 512 * 2;
constexpr size_t WS_GV = WS_GU + (size_t)ML * 1024 * 2;
constexpr size_t WS_Q = WS_GV + (size_t)ML * 1024 * 2;
constexpr size_t WS_K = WS_Q + (size_t)ML * 1536 * 2;
constexpr size_t WS_V = WS_K + (size_t)MT * 1536 * 2;
constexpr size_t WS_L1END = WS_V + (size_t)MT * 1024 * 2;
constexpr size_t WS_ACT1 = WS_AR;
constexpr size_t WS_HNP = WS_AR + AR_BYTES;
constexpr size_t WS_PART = WS_HNP + (size_t)NEXP * ML * DM;
constexpr size_t WS_MCM = WS_PART + (size_t)4 * MC * DM * 4;
constexpr size_t WS_MRS = WS_MCM + (size_t)NEXP * 14336 * 4;
constexpr size_t WS_END = WS_MRS + (size_t)NEXP * ML * 4;
constexpr int CW_MOEMAX = 120000;
static_assert(WS_Z + (size_t)MT * 1024 * 2 <= WS_END && WS_L1END <= WS_END, "arena");
static_assert((size_t)MOE_ROWS * DM * 2 == 2 * (size_t)MT * DM * 2, "YB overlays HN|Y0");

constexpr int LDS_BYTES = 147456;
constexpr int LDS_MISC = 131072;

__device__ __forceinline__ unsigned cvt_pk_bf16(float lo, float hi) { unsigned r; asm("v_cvt_pk_bf16_f32 %0, %1, %2" : "=v"(r) : "v"(lo), "v"(hi)); return r; }
__device__ __forceinline__ float clamp448(float x) { return __builtin_amdgcn_fmed3f(x, -448.0f, 448.0f); }
__device__ __forceinline__ unsigned cvt4_fp8(float a, float b, float c, float d) { int w = 0; w = __builtin_amdgcn_cvt_pk_fp8_f32(clamp448(a), clamp448(b), w, false); w = __builtin_amdgcn_cvt_pk_fp8_f32(clamp448(c), clamp448(d), w, true); return (unsigned)w; }
__device__ __forceinline__ unsigned cvt4_i8(float a, float b, float c, float d) {
    constexpr float M = 12582912.0f;
    const unsigned ua = __float_as_uint(__builtin_amdgcn_fmed3f(a + M, M - 127.f, M + 127.f)), ub = __float_as_uint(__builtin_amdgcn_fmed3f(b + M, M - 127.f, M + 127.f));
    const unsigned uc = __float_as_uint(__builtin_amdgcn_fmed3f(c + M, M - 127.f, M + 127.f)), ud = __float_as_uint(__builtin_amdgcn_fmed3f(d + M, M - 127.f, M + 127.f));
    const unsigned t01 = __builtin_amdgcn_perm(ub, ua, 0x0c0c0400u), t23 = __builtin_amdgcn_perm(ud, uc, 0x0c0c0400u);
    return __builtin_amdgcn_perm(t23, t01, 0x05040100u); }
__device__ __forceinline__ float bf_lo(unsigned w) { return __uint_as_float(w << 16); }
__device__ __forceinline__ float bf_hi(unsigned w) { return __uint_as_float(w & 0xffff0000u); }
__device__ __forceinline__ f32x4 ld4_bf(const bf16_t* p) { const u32x2 w = *(const u32x2*)p; return (f32x4){bf_lo(w.x), bf_hi(w.x), bf_lo(w.y), bf_hi(w.y)}; }
__device__ __forceinline__ void st4_bf(bf16_t* p, const f32x4 v) { u32x2 w; w.x = cvt_pk_bf16(v[0], v[1]); w.y = cvt_pk_bf16(v[2], v[3]); *(u32x2*)p = w; }
__device__ __forceinline__ float wave_sum(float v) {
#pragma unroll
    for (int o = 1; o < 64; o <<= 1) v += __shfl_xor(v, o);
    return v;
}
__device__ __forceinline__ int tid_opaque() { int t = threadIdx.x; asm volatile("" : "+v"(t)); return t; }
__device__ __forceinline__ float sum4(const f32x4 v) { return (v[0] + v[1]) + (v[2] + v[3]); }
__device__ __forceinline__ float sq4(const f32x4 v) { return (v[0] * v[0] + v[1] * v[1]) + (v[2] * v[2] + v[3] * v[3]); }
__device__ __forceinline__ float sigmoidf_(float x) { return __builtin_amdgcn_rcpf(1.0f + __expf(-x)); }
__device__ __forceinline__ float siluf_(float x) { return x * sigmoidf_(x); }
__device__ __forceinline__ float gelu_tanh(float x) { const float u = 0.7978845608028654f * (x + 0.044715f * x * x * x); return x * sigmoidf_(2.0f * u); }
__device__ __forceinline__ int v_pos(int kk) { return (((kk >> 2) & 1) << 5) + ((kk >> 5) << 4) + (kk & 3) + 4 * ((kk >> 3) & 3); }
__device__ __forceinline__ int krow_of(int r) { return r < ML ? (r >> 12) * KVL + CTXL + (r & 4095) : ((r - ML) >> 8) * KVL + ((r - ML) & 255); }
__device__ __forceinline__ int cond_of(int r) { return r < ML ? (r >> 12) : 4; }

#define XB_TMO      128
#define XB_XCNT(j)  (256  + 64 * (j))
#define XB_XSUB(j)  (1280 + 64 * (j))
#define XB_XGEN(j)  (2304 + 64 * (j))
#define XB_TOP      3328
#define XB_TOPGEN   3392
#define XCD_BAR_WORDS 3456
#define XB_SPIN_CAP (1u << 18)
__device__ __forceinline__ unsigned xb_ld(unsigned* p)              { return __hip_atomic_load(p, __ATOMIC_RELAXED, __HIP_MEMORY_SCOPE_AGENT); }
__device__ __forceinline__ unsigned xb_add(unsigned* p, unsigned v) { return __hip_atomic_fetch_add(p, v, __ATOMIC_RELAXED, __HIP_MEMORY_SCOPE_AGENT); }
__device__ __forceinline__ unsigned xb_xcc_id() { return (unsigned)__builtin_amdgcn_s_getreg((3 << 11) | 20) & 0xFu; }
#define XB_SPIN(cond, bar) do { unsigned _sp = 0; while (cond) { __builtin_amdgcn_s_sleep(1); \
    if ((++_sp & 255u) == 0u) { if (xb_ld(&(bar)[XB_TMO])) break; if (_sp > XB_SPIN_CAP) { atomicAdd(&(bar)[XB_TMO], 1u); break; } } } } while (0)
struct XcdBarrier { unsigned* bar; unsigned x; volatile LAS unsigned* st; unsigned G; };
__device__ __forceinline__ XcdBarrier xcd_barrier_post(unsigned* bar, volatile LAS unsigned* st) {
    XcdBarrier b; b.bar = bar; b.x = xb_xcc_id(); b.st = st; b.G = gridDim.x;
    if (threadIdx.x == 0) (void)xb_add(&bar[XB_XCNT(b.x)], 1u);
    return b;
}
__device__ __forceinline__ void xcd_barrier_complete(unsigned* bar, unsigned x, unsigned G, unsigned& nloc, unsigned& nx) {
    unsigned sum, cnt, mine, sp = 0u;
    for (;;) {
        sum = 0u; cnt = 0u; mine = 0u;
#pragma unroll
        for (unsigned j = 0; j < 16; ++j) { const unsigned c = xb_ld(&bar[XB_XCNT(j)]); sum += c; cnt += (c > 0u) ? 1u : 0u; mine = (j == x) ? c : mine; }
        if (sum == G) break;
        __builtin_amdgcn_s_sleep(1);
        if ((++sp & 255u) == 0u) { if (xb_ld(&bar[XB_TMO])) break; if (sp > XB_SPIN_CAP) { atomicAdd(&bar[XB_TMO], 1u); break; } }
    }
    nloc = mine > 0u ? mine : 1u; nx = cnt > 0u ? cnt : 1u;
}
__device__ __forceinline__ void xcd_barrier(const XcdBarrier& b) {
    asm volatile("s_waitcnt vmcnt(0)" ::: "memory");
    __syncthreads();
    int t_ = threadIdx.x; asm volatile("" : "+v"(t_));
    if (t_ == 0) {
        unsigned* bar = b.bar;
        __builtin_amdgcn_s_waitcnt(0);
        unsigned nloc = b.st[0], nx = b.st[1];
        if (nloc == 0u) { xcd_barrier_complete(bar, b.x, b.G, nloc, nx); b.st[0] = nloc; b.st[1] = nx; }
        const unsigned old = xb_add(&bar[XB_XSUB(b.x)], 1u);
        const unsigned gen = old / nloc;
        if (old + 1u == (gen + 1u) * nloc) {
            __builtin_amdgcn_fence(__ATOMIC_RELEASE, "agent");
            asm volatile("s_waitcnt vmcnt(0)" ::: "memory");
            const unsigned og = xb_add(&bar[XB_TOP], 1u);
            const unsigned tg = og / nx;
            if (og + 1u == (tg + 1u) * nx) xb_add(&bar[XB_TOPGEN], 1u);
            else XB_SPIN(xb_ld(&bar[XB_TOPGEN]) == tg, bar);
            __builtin_amdgcn_fence(__ATOMIC_ACQUIRE, "agent");
            xb_add(&bar[XB_XGEN(b.x)], 1u);
            asm volatile("s_waitcnt vmcnt(0)" ::: "memory");
        } else {
            XB_SPIN(xb_ld(&bar[XB_XGEN(b.x)]) == gen, bar);
            __builtin_amdgcn_fence(__ATOMIC_ACQUIRE, "agent");
            asm volatile("s_waitcnt vmcnt(0)" ::: "memory");
        }
    }
    __syncthreads();
}

namespace pg8 {
constexpr int BM = 256, BK = 64, HALF = 128, HTB = HALF * BK * 2, STAGE_BYTES = 8 * HTB, NXCD = 8, WGM = 8;
__device__ __forceinline__ int lds_byte(int r, int c) { const int st = (r >> 4) * 2 + (c >> 5), rr = r & 15, cc = c & 31, ob = rr * 64 + cc * 2; return st * 1024 + (ob ^ (((ob >> 9) & 1) << 5)); }
__device__ __forceinline__ void stage_rc(int b, int& R, int& C) { const int st = b / 1024, sb = b % 1024, swz = sb ^ (((sb >> 9) & 1) << 5); R = (st >> 1) * 16 + swz / 64; C = (st & 1) * 32 + (swz % 64) / 2; }
__device__ __forceinline__ int perm32(int rho) { const int n = rho >> 4, i = rho & 15; return 8 * (i >> 2) + 4 * n + (i & 3); }

struct Unit { int pm, pn, g, orow0, kt0, nt; };

__device__ __forceinline__ void tile_map(int id, int nM, int nN, int& pm, int& pn) {
    const int nwg = nM * nN;
    int wgid = id; { const int q = nwg / NXCD, r = nwg % NXCD, xcd = wgid % NXCD, off = wgid / NXCD; wgid = (xcd < r ? xcd * (q + 1) : r * (q + 1) + (xcd - r) * q) + off; }
    const int nig = WGM * nN, gid = wgid / nig, fm = gid * WGM, gsz = (nM - fm) < WGM ? (nM - fm) : WGM;
    pm = fm + ((wgid % nig) % gsz); pn = (wgid % nig) / gsz;
}

struct DenseSched {
    const char* Bt; int lda, ldb, G, c; int nM0, nN0, nM1, nN1, pm1, pn1; int ntK, ksplit;
    __device__ __forceinline__ bool next(int i, Unit& u) const {
        const int L = i * G + c; const int n0 = nM0 * nN0;
        if (L < n0) { tile_map(L, nM0, nN0, u.pm, u.pn); u.g = -1; u.kt0 = 0; u.nt = ntK; }
        else { const int l2 = L - n0; if (l2 >= nM1 * nN1 * ksplit) return false; int a, b; const int part = l2 % ksplit; tile_map(l2 / ksplit, nM1, nN1, a, b); u.pm = pm1 + a; u.pn = pn1 + b;
            if (ksplit > 1) { u.g = part; u.nt = ntK / ksplit; u.kt0 = part * u.nt; } else { u.g = -1; u.kt0 = 0; u.nt = ntK; } }
        u.orow0 = u.pm * BM; return true;
    }
    __device__ __forceinline__ const char* Bptr(const Unit& u) const { return Bt + (size_t)u.pn * BM * ldb * 2 + (size_t)u.kt0 * (BK * 2); }
    __device__ __forceinline__ unsigned Aoff(const Unit& u, int rloc) const { return (unsigned)(u.pm * BM + rloc) * (unsigned)lda * 2u + (unsigned)u.kt0 * (BK * 2); }
};
struct QKVSched {
    const char* Bq; const char* Bkv; unsigned aoff1; int lda, ldb, G, c;
    __device__ __forceinline__ bool next(int i, Unit& u) const {
        const int L = i * G + c; constexpr int n0 = (ML / 256) * 6, n1 = (MT / 256) * 8;
        if (L < n0) { tile_map(L, ML / 256, 6, u.pm, u.pn); u.g = 0; } else { if (L - n0 >= n1) return false; tile_map(L - n0, MT / 256, 8, u.pm, u.pn); u.g = 1; }
        u.orow0 = u.pm * BM; u.kt0 = 0; u.nt = 8; return true;
    }
    __device__ __forceinline__ const char* Bptr(const Unit& u) const { return (u.g ? Bkv : Bq) + (size_t)u.pn * BM * ldb * 2; }
    __device__ __forceinline__ unsigned Aoff(const Unit& u, int rloc) const { return (u.g ? aoff1 : 0u) + (unsigned)(u.pm * BM + rloc) * (unsigned)lda * 2u; }
};
struct MoeSched {
    const char* Bt; const int* list; volatile LAS int* tab; int lda, ldb, G, c, nN, gather; size_t bstride; int ntK;
    __device__ __forceinline__ bool next(int i, Unit& u) const {
        const int L = i * G + c; if (L >= tab[24]) return false;
        int e = 0;
#pragma unroll
        for (int j = 1; j < 8; ++j) e += (L >= tab[16 + j]) ? 1 : 0;
        const int cnt = tab[e], np = (cnt + 255) >> 8;
        tile_map(L - tab[16 + e], np, nN, u.pm, u.pn); u.g = e; u.orow0 = (tab[8 + e] + u.pm) * BM; u.kt0 = 0; u.nt = ntK; return true;
    }
    __device__ __forceinline__ const char* Bptr(const Unit& u) const { return Bt + (size_t)u.g * bstride + (size_t)u.pn * BM * ldb * 2; }
    __device__ __forceinline__ unsigned Aoff(const Unit& u, int rloc) const {
        if (gather) return (unsigned)(u.g * ML + u.pm * BM + rloc) * (unsigned)lda * 2u;
        return (unsigned)(u.orow0 + rloc) * (unsigned)lda * 2u;
    }
};

typedef int i32x8 __attribute__((ext_vector_type(8)));
typedef int i32x4v __attribute__((ext_vector_type(4)));
template <class Epi, class Sched, int FP8 = 0>
__device__ __forceinline__ void gemm_phase(LAS unsigned char* lds, const char* Abase, const int K, const Sched& S, const Epi& E) {
    const int tid = threadIdx.x, wid = __builtin_amdgcn_readfirstlane(tid >> 6), lane = tid & 63, wr = wid >> 2, wc = wid & 3, fr = lane & 15, fq = lane >> 4;
    (void)K;
    int Rr[2], Cc[2]; unsigned voffB[2];
#pragma unroll
    for (int i = 0; i < 2; ++i) { stage_rc(tid * 16 + i * 8192, Rr[i], Cc[i]); const int Rb = Epi::PERM ? ((Rr[i] & ~31) + perm32(Rr[i] & 31)) : Rr[i];
        voffB[i] = (unsigned)(Rb * S.ldb + Cc[i]) * 2u; }
    const size_t kstep = (size_t)(BK * 2);
    const size_t hstepB = (size_t)HALF * S.ldb * 2;
    const unsigned ldsw = (unsigned)wid * 1024u;
    const int aoff = lds_byte(wr * 64 + fr, fq * 8), boff = lds_byte(wc * 32 + fr, fq * 8);
#define PG8_SA(b, h) (((b) * 2 + (h)) * HTB)
#define PG8_SB(b, h) ((4 + (b) * 2 + (h)) * HTB)
#define PG8_STAGE(bufoff, gbase, voff) do { _Pragma("unroll") for (int _i = 0; _i < 2; ++_i) { unsigned vo_ = (voff)[_i]; asm volatile("" : "+v"(vo_));   \
        __builtin_amdgcn_global_load_lds((const unsigned*)((const char*)(gbase) + vo_), (LAS unsigned*)(lds + (bufoff) + ldsw + _i * 8192), 16, 0, 0); } } while (0)
#define PG8_LDA(dst, b, h) do { _Pragma("unroll") for (int m = 0; m < 4; ++m) _Pragma("unroll") for (int k = 0; k < 2; ++k) dst[m][k] = *(const LAS bf16x8*)(lds + PG8_SA(b, h) + aoff + m * 2048 + k * 1024); } while (0)
#define PG8_LDB(dst, b, h) do { _Pragma("unroll") for (int n = 0; n < 2; ++n) _Pragma("unroll") for (int k = 0; k < 2; ++k) dst[n][k] = *(const LAS bf16x8*)(lds + PG8_SB(b, h) + boff + n * 2048 + k * 1024); } while (0)
#define PG8_CAT8(x) (i32x8){((const int*)&(x)[0])[0], ((const int*)&(x)[0])[1], ((const int*)&(x)[0])[2], ((const int*)&(x)[0])[3], ((const int*)&(x)[1])[0], ((const int*)&(x)[1])[1], ((const int*)&(x)[1])[2], ((const int*)&(x)[1])[3]}
#define PG8_MMA(ai, bj, At, Bt) do { __builtin_amdgcn_s_setprio(1); _Pragma("unroll") for (int m = 0; m < 4; ++m) _Pragma("unroll") for (int n = 0; n < 2; ++n) { \
        if constexpr (FP8 == 1) acc[ai][bj][m][n] = __builtin_amdgcn_mfma_scale_f32_16x16x128_f8f6f4(PG8_CAT8(Bt[n]), PG8_CAT8(At[m]), acc[ai][bj][m][n], 0, 0, 0, 127, 0, 127); \
        else if constexpr (FP8 == 2) { _Pragma("unroll") for (int k = 0; k < 2; ++k) acc[ai][bj][m][n] = __builtin_bit_cast(f32x4, __builtin_amdgcn_mfma_i32_16x16x64_i8(__builtin_bit_cast(i32x4v, Bt[n][k]), __builtin_bit_cast(i32x4v, At[m][k]), __builtin_bit_cast(i32x4v, acc[ai][bj][m][n]), 0, 0, 0)); } \
        else { _Pragma("unroll") for (int k = 0; k < 2; ++k) acc[ai][bj][m][n] = __builtin_amdgcn_mfma_f32_16x16x32_bf16(Bt[n][k], At[m][k], acc[ai][bj][m][n], 0, 0, 0); } } \
        __builtin_amdgcn_s_setprio(0); } while (0)
#define PG8_WAIT_V(n) asm volatile("s_waitcnt vmcnt(" #n ")" ::: "memory")
#define PG8_WAIT_L(n) asm volatile("s_waitcnt lgkmcnt(" #n ")" ::: "memory")
#define PG8_BAR __builtin_amdgcn_s_barrier()
#define PG8_SCHED __builtin_amdgcn_sched_barrier(0)
#define PG8_AOFFS(dst, un) do { _Pragma("unroll") for (int _h = 0; _h < 2; ++_h) _Pragma("unroll") for (int _i = 0; _i < 2; ++_i) dst[_h][_i] = S.Aoff(un, _h * HALF + Rr[_i]) + (unsigned)Cc[_i] * 2u; } while (0)
    Unit cur, nxt; int ui = 0;
    if (!S.next(0, cur)) return;
    f32x4 acc[2][2][4][2];
#pragma unroll
    for (int a = 0; a < 2; ++a)
#pragma unroll
        for (int b = 0; b < 2; ++b)
#pragma unroll
            for (int m = 0; m < 4; ++m)
#pragma unroll
                for (int n = 0; n < 2; ++n) acc[a][b][m][n] = (f32x4){0.f, 0.f, 0.f, 0.f};
    bf16x8 At[4][2], B0[2][2], B1[2][2];
    unsigned va[2][2];
    PG8_AOFFS(va, cur);
    const char* cB = S.Bptr(cur);
    PG8_STAGE(PG8_SB(0, 0), cB, voffB); PG8_STAGE(PG8_SB(0, 1), cB + hstepB, voffB); PG8_STAGE(PG8_SA(0, 0), Abase, va[0]); PG8_STAGE(PG8_SA(0, 1), Abase, va[1]);
    if (wr == 1) PG8_BAR;
    PG8_WAIT_V(2); PG8_BAR;
    PG8_STAGE(PG8_SB(1, 0), cB + kstep, voffB); PG8_STAGE(PG8_SA(1, 0), Abase + kstep, va[0]); PG8_STAGE(PG8_SB(1, 1), cB + hstepB + kstep, voffB);
    PG8_WAIT_V(6); PG8_BAR;
    for (;;) {
        const bool has_next = S.next(ui + 1, nxt);
        const char* nB = has_next ? S.Bptr(nxt) : cB;
        const int nt = cur.nt;
        for (int t = 0; t < nt; t += 2) {
            const bool last = (t == nt - 2);
            const char* a1 = Abase + (size_t)(t + 1) * kstep;
            const char* a2 = Abase + (last ? (size_t)0 : (size_t)(t + 2) * kstep); const char* b2 = last ? nB : cB + (size_t)(t + 2) * kstep;
            const char* a3 = a2 + kstep; const char* b3 = b2 + kstep;
            PG8_LDB(B0, 0, 0); PG8_LDB(B1, 0, 1); PG8_SCHED; PG8_LDA(At, 0, 0); PG8_STAGE(PG8_SA(1, 1), a1, va[1]);
            PG8_WAIT_V(8); PG8_WAIT_L(0); PG8_BAR; PG8_MMA(0, 0, At, B0); PG8_MMA(0, 1, At, B1); PG8_BAR; PG8_SCHED;
            if (last && has_next) { PG8_AOFFS(va, nxt); }
            PG8_LDA(At, 0, 1); PG8_STAGE(PG8_SB(0, 0), b2, voffB); PG8_STAGE(PG8_SB(0, 1), b2 + hstepB, voffB); PG8_STAGE(PG8_SA(0, 0), a2, va[0]);
            PG8_WAIT_V(8); PG8_WAIT_L(0); PG8_BAR; PG8_MMA(1, 0, At, B0); PG8_MMA(1, 1, At, B1); PG8_BAR; PG8_SCHED;
            PG8_LDB(B0, 1, 0); PG8_LDB(B1, 1, 1); PG8_SCHED; PG8_LDA(At, 1, 0); PG8_STAGE(PG8_SA(0, 1), a2, va[1]);
            PG8_WAIT_V(8); PG8_WAIT_L(0); PG8_BAR; PG8_MMA(0, 0, At, B0); PG8_MMA(0, 1, At, B1); PG8_BAR; PG8_SCHED;
            PG8_LDA(At, 1, 1); PG8_STAGE(PG8_SB(1, 0), b3, voffB); PG8_STAGE(PG8_SB(1, 1), b3 + hstepB, voffB); PG8_STAGE(PG8_SA(1, 0), a3, va[0]);
            PG8_WAIT_V(8); PG8_WAIT_L(0); PG8_BAR; PG8_MMA(1, 0, At, B0); PG8_MMA(1, 1, At, B1); PG8_BAR; PG8_SCHED;
        }
        if (wr == 0) PG8_BAR;
        E(acc, cur, wr, wc, fr, fq);
        if (!has_next) break;
#pragma unroll
        for (int a = 0; a < 2; ++a)
#pragma unroll
            for (int b = 0; b < 2; ++b)
#pragma unroll
                for (int m = 0; m < 4; ++m)
#pragma unroll
                    for (int n = 0; n < 2; ++n) acc[a][b][m][n] = (f32x4){0.f, 0.f, 0.f, 0.f};
        cur = nxt; cB = nB; ++ui;
        if (wr == 1) PG8_BAR;
    }
    PG8_WAIT_V(0);
    PG8_BAR;
#undef PG8_SA
#undef PG8_SB
#undef PG8_STAGE
#undef PG8_LDA
#undef PG8_LDB
#undef PG8_MMA
#undef PG8_CAT8
#undef PG8_WAIT_V
#undef PG8_WAIT_L
#undef PG8_BAR
#undef PG8_SCHED
#undef PG8_AOFFS
}

typedef f32x4 AccT[2][2][4][2];
__device__ __forceinline__ u32x4 pack8(const f32x4 a, const f32x4 b) { u32x4 w; w.x = cvt_pk_bf16(a[0], a[1]); w.y = cvt_pk_bf16(a[2], a[3]); w.z = cvt_pk_bf16(b[0], b[1]); w.w = cvt_pk_bf16(b[2], b[3]); return w; }
__device__ __forceinline__ float quad_row_sum(float s) { s += __shfl_xor(s, 16); s += __shfl_xor(s, 32); return s; }

struct EpiEIn {
    static constexpr bool PERM = true;
    bf16_t* U; bf16_t* Z; const float* rsc; const float* cmax;
    __device__ __forceinline__ void operator()(const AccT& acc, const Unit& u, int wr, int wc, int fr, int fq) const {
        const int row0 = u.orow0 + wr * 64 + fr, cw = wc * 32 + 8 * fq;
        f32x4 cs[2][2];
#pragma unroll
        for (int bj = 0; bj < 2; ++bj)
#pragma unroll
            for (int n = 0; n < 2; ++n) cs[bj][n] = *(const f32x4*)(cmax + u.pn * 256 + bj * HALF + cw + 4 * n) * (1.0f / 127.0f);
#define DQ(ai, bj, m, n) (__builtin_convertvector(__builtin_bit_cast(i32x4v, acc[ai][bj][m][n]), f32x4) * (cs[bj][n] * rs))
        if (u.pn < 4) {
#pragma unroll
            for (int ai = 0; ai < 2; ++ai)
#pragma unroll
                for (int m = 0; m < 4; ++m) { const int row = row0 + ai * HALF + m * 16; const float rs = rsc[row]; bf16_t* rp = U + (size_t)row * 1024 + u.pn * 256 + cw;
#pragma unroll
                    for (int bj = 0; bj < 2; ++bj) *(u32x4*)(rp + bj * HALF) = pack8(DQ(ai, bj, m, 0), DQ(ai, bj, m, 1)); }
        } else {
            const int cb = (u.pn - 4) * 128 + cw;
#pragma unroll
            for (int ai = 0; ai < 2; ++ai)
#pragma unroll
                for (int m = 0; m < 4; ++m) { const int row = row0 + ai * HALF + m * 16; const float rs = rsc[row]; f32x4 z0, z1; const f32x4 a0 = DQ(ai, 0, m, 0), a1 = DQ(ai, 0, m, 1), g0 = DQ(ai, 1, m, 0), g1 = DQ(ai, 1, m, 1);
#pragma unroll
                    for (int j = 0; j < 4; ++j) { z0[j] = a0[j] * sigmoidf_(g0[j]); z1[j] = a1[j] * sigmoidf_(g1[j]); }
                    *(u32x4*)(Z + (size_t)row * 1024 + cb) = pack8(z0, z1); }
        }
#undef DQ
    }
};
struct EpiSwiGLU {
    static constexpr bool PERM = true;
    bf16_t* O; int ldo;
    __device__ __forceinline__ void operator()(const AccT& acc, const Unit& u, int wr, int wc, int fr, int fq) const {
        const int row0 = u.orow0 + wr * 64 + fr, cb = u.pn * 128 + wc * 32 + 8 * fq;
#pragma unroll
        for (int ai = 0; ai < 2; ++ai)
#pragma unroll
            for (int m = 0; m < 4; ++m) { f32x4 z0, z1;
#pragma unroll
                for (int j = 0; j < 4; ++j) { z0[j] = siluf_(acc[ai][0][m][0][j]) * acc[ai][1][m][0][j]; z1[j] = siluf_(acc[ai][0][m][1][j]) * acc[ai][1][m][1][j]; }
                *(u32x4*)(O + (size_t)(row0 + ai * HALF + m * 16) * ldo + cb) = pack8(z0, z1); }
    }
};
struct EpiSwiGLUi8 {
    static constexpr bool PERM = true;
    bf16_t* O; int ldo; const float* rsc; const float* cmax; float sout8;
    __device__ __forceinline__ void operator()(const AccT& acc, const Unit& u, int wr, int wc, int fr, int fq) const {
        const int row0 = u.orow0 + wr * 64 + fr, cb = u.pn * 128 + wc * 32 + 8 * fq, nb = u.pn * 256 + wc * 32 + 8 * fq;
        f32x4 cg0 = *(const f32x4*)(cmax + nb) * (1.0f / 127.0f), cg1 = *(const f32x4*)(cmax + nb + 4) * (1.0f / 127.0f), cu0 = *(const f32x4*)(cmax + nb + 128) * (1.0f / 127.0f), cu1 = *(const f32x4*)(cmax + nb + 132) * (1.0f / 127.0f);
#pragma unroll
        for (int ai = 0; ai < 2; ++ai)
#pragma unroll
            for (int m = 0; m < 4; ++m) { const int row = row0 + ai * HALF + m * 16; const float rs = rsc[row]; f32x4 z0, z1;
                const i32x4v g0 = __builtin_bit_cast(i32x4v, acc[ai][0][m][0]), g1 = __builtin_bit_cast(i32x4v, acc[ai][0][m][1]), u0 = __builtin_bit_cast(i32x4v, acc[ai][1][m][0]), u1 = __builtin_bit_cast(i32x4v, acc[ai][1][m][1]);
#pragma unroll
                for (int j = 0; j < 4; ++j) { z0[j] = siluf_((float)g0[j] * (rs * cg0[j])) * ((float)u0[j] * (rs * cu0[j])); z1[j] = siluf_((float)g1[j] * (rs * cg1[j])) * ((float)u1[j] * (rs * cu1[j])); }
                if (sout8 > 0.f) { u32x2 w; w.x = cvt4_fp8(z0[0] * sout8, z0[1] * sout8, z0[2] * sout8, z0[3] * sout8); w.y = cvt4_fp8(z1[0] * sout8, z1[1] * sout8, z1[2] * sout8, z1[3] * sout8); *(u32x2*)((unsigned char*)O + (size_t)row * ldo + cb) = w; }
                else *(u32x4*)(O + (size_t)row * ldo + cb) = pack8(z0, z1);
                __builtin_amdgcn_sched_barrier(0); }
    }
};
struct EpiSwiGLUi8M {
    static constexpr bool PERM = true;
    unsigned char* O; int ldo; const float* rsc; const float* cmax; float sout8;
    __device__ __forceinline__ void operator()(const AccT& acc, const Unit& u, int wr, int wc, int fr, int fq) const {
        const int rl0 = wr * 64 + fr, cb = u.pn * 128 + wc * 32 + 8 * fq, nb = u.g * 14336 + u.pn * 256 + wc * 32 + 8 * fq;
        const float* rs_p = rsc + (size_t)u.g * ML + u.pm * BM;
        f32x4 cg0 = *(const f32x4*)(cmax + nb) * (1.0f / 127.0f), cg1 = *(const f32x4*)(cmax + nb + 4) * (1.0f / 127.0f), cu0 = *(const f32x4*)(cmax + nb + 128) * (1.0f / 127.0f), cu1 = *(const f32x4*)(cmax + nb + 132) * (1.0f / 127.0f);
#pragma unroll
        for (int ai = 0; ai < 2; ++ai)
#pragma unroll
            for (int m = 0; m < 4; ++m) { const int rl = rl0 + ai * HALF + m * 16; const float rs = rs_p[rl]; f32x4 z0, z1;
                const i32x4v g0 = __builtin_bit_cast(i32x4v, acc[ai][0][m][0]), g1 = __builtin_bit_cast(i32x4v, acc[ai][0][m][1]), u0 = __builtin_bit_cast(i32x4v, acc[ai][1][m][0]), u1 = __builtin_bit_cast(i32x4v, acc[ai][1][m][1]);
#pragma unroll
                for (int j = 0; j < 4; ++j) { z0[j] = siluf_((float)g0[j] * (rs * cg0[j])) * ((float)u0[j] * (rs * cu0[j])); z1[j] = siluf_((float)g1[j] * (rs * cg1[j])) * ((float)u1[j] * (rs * cu1[j])); }
                u32x2 w; w.x = cvt4_fp8(z0[0] * sout8, z0[1] * sout8, z0[2] * sout8, z0[3] * sout8); w.y = cvt4_fp8(z1[0] * sout8, z1[1] * sout8, z1[2] * sout8, z1[3] * sout8);
                *(u32x2*)(O + (size_t)(u.orow0 + rl) * ldo + cb) = w;
                __builtin_amdgcn_sched_barrier(0); }
    }
};
struct EpiSwiGLU8 {
    static constexpr bool PERM = true;
    unsigned char* O; int ldo; float sin_, sout;
    __device__ __forceinline__ void operator()(const AccT& acc, const Unit& u, int wr, int wc, int fr, int fq) const {
        const int row0 = u.orow0 + wr * 64 + fr, cb = u.pn * 128 + wc * 32 + 8 * fq;
#pragma unroll
        for (int ai = 0; ai < 2; ++ai)
#pragma unroll
            for (int m = 0; m < 4; ++m) { f32x4 z0, z1;
#pragma unroll
                for (int j = 0; j < 4; ++j) { z0[j] = siluf_(acc[ai][0][m][0][j] * sin_) * (acc[ai][1][m][0][j] * (sin_ * sout)); z1[j] = siluf_(acc[ai][0][m][1][j] * sin_) * (acc[ai][1][m][1][j] * (sin_ * sout)); }
                u32x2 w; w.x = cvt4_fp8(z0[0], z0[1], z0[2], z0[3]); w.y = cvt4_fp8(z1[0], z1[1], z1[2], z1[3]);
                *(u32x2*)(O + (size_t)(row0 + ai * HALF + m * 16) * ldo + cb) = w; __builtin_amdgcn_sched_barrier(0); }
    }
};
template <class BT>
struct EpiResT {
    static constexpr bool PERM = false;
    const BT* bl; const BT* bc; bf16_t* out; const float* gate; float scale;
    static __device__ __forceinline__ f32x4 ldb(const float* p) { return *(const f32x4*)p; }
    static __device__ __forceinline__ f32x4 ldb(const bf16_t* p) { return ld4_bf(p); }
    __device__ __forceinline__ void operator()(const AccT& acc, const Unit& u, int wr, int wc, int fr, int fq) const {
        const int cnd = cond_of(u.orow0);
        const BT* bp = (u.orow0 < ML) ? bl + (size_t)u.orow0 * DM : bc + (size_t)(u.orow0 - ML) * DM;
        bf16_t* op = out + (size_t)u.orow0 * DM;
        const int rl0 = wr * 64 + fr, col0 = u.pn * BM + wc * 32 + 4 * fq;
        f32x4 gv[2][2];
#pragma unroll
        for (int bj = 0; bj < 2; ++bj)
#pragma unroll
            for (int n = 0; n < 2; ++n) gv[bj][n] = *(const f32x4*)(gate + (size_t)cnd * NMOD + col0 + bj * HALF + n * 16) * scale;
#pragma unroll
        for (int ai = 0; ai < 2; ++ai)
#pragma unroll
            for (int m = 0; m < 4; ++m) { const size_t off = (size_t)(rl0 + ai * HALF + m * 16) * DM + col0;
#pragma unroll
                for (int bj = 0; bj < 2; ++bj)
#pragma unroll
                    for (int n = 0; n < 2; ++n) { const f32x4 bs = ldb(bp + off + bj * HALF + n * 16); st4_bf(op + off + bj * HALF + n * 16, bs + gv[bj][n] * acc[ai][bj][m][n]); }
                asm volatile("" ::: "memory"); }
    }
};
struct EpiPart {
    static constexpr bool PERM = false;
    float* part; const float* gate; float scale;
    __device__ __forceinline__ void operator()(const AccT& acc, const Unit& u, int wr, int wc, int fr, int fq) const {
        const int rl0 = wr * 64 + fr, col0 = u.pn * BM + wc * 32 + 4 * fq;
        float* op = part + ((size_t)u.g * MC + (u.orow0 - ML)) * DM;
        f32x4 gv[2][2];
#pragma unroll
        for (int bj = 0; bj < 2; ++bj)
#pragma unroll
            for (int n = 0; n < 2; ++n) gv[bj][n] = *(const f32x4*)(gate + (size_t)4 * NMOD + col0 + bj * HALF + n * 16) * scale;
#pragma unroll
        for (int ai = 0; ai < 2; ++ai)
#pragma unroll
            for (int m = 0; m < 4; ++m) { const size_t off = (size_t)(rl0 + ai * HALF + m * 16) * DM + col0;
#pragma unroll
                for (int bj = 0; bj < 2; ++bj)
#pragma unroll
                    for (int n = 0; n < 2; ++n) *(f32x4*)(op + off + bj * HALF + n * 16) = gv[bj][n] * acc[ai][bj][m][n]; }
    }
};
struct EpiOIn {
    static constexpr bool PERM = true;
    bf16_t *CQ, *CKV, *GU, *GV; unsigned char* KB; float *ssq_q, *ssq_kv, *zs1, *zs2; const float* rope; const float* rsc; const float* cmax;
    __device__ __forceinline__ void operator()(const AccT& acc, const Unit& u, int wr, int wc, int fr, int fq) const {
        const int row0 = u.orow0 + wr * 64 + fr, cw = wc * 32 + 8 * fq; const int pn = u.pn;
        f32x4 cs[2][2];
#pragma unroll
        for (int bj = 0; bj < 2; ++bj)
#pragma unroll
            for (int n = 0; n < 2; ++n) cs[bj][n] = *(const f32x4*)(cmax + pn * 256 + bj * HALF + cw + 4 * n) * (1.0f / 127.0f);
#define DQ(ai, bj, m, n) (__builtin_convertvector(__builtin_bit_cast(i32x4v, acc[ai][bj][m][n]), f32x4) * (cs[bj][n] * rs))
        if (pn < 4) {
            bf16_t* O = pn < 2 ? CQ : CKV; float* ss = pn < 2 ? ssq_q : ssq_kv; const int cb = (pn & 1) * 256 + cw;
#pragma unroll
            for (int ai = 0; ai < 2; ++ai)
#pragma unroll
                for (int m = 0; m < 4; ++m) { const int row = row0 + ai * HALF + m * 16; const float rs = rsc[row]; float s = 0.f;
#pragma unroll
                    for (int bj = 0; bj < 2; ++bj) { const f32x4 v0 = DQ(ai, bj, m, 0), v1 = DQ(ai, bj, m, 1); *(u32x4*)(O + (size_t)row * 512 + cb + bj * HALF) = pack8(v0, v1); s += sq4(v0) + sq4(v1); }
                    s = quad_row_sum(s); if (fq == 0) unsafeAtomicAdd(ss + row, s); }
        } else if (pn == 4) {
            if (wc < 2) {
                const bool lat = u.orow0 < ML;
#pragma unroll
                for (int ai = 0; ai < 2; ++ai)
#pragma unroll
                    for (int m = 0; m < 4; ++m) { const int row = row0 + ai * HALF + m * 16; const float rs = rsc[row]; f32x4 x1 = DQ(ai, 0, m, 0), x2 = DQ(ai, 0, m, 1), o1 = x1, o2 = x2;
                        if (lat) { const int t = row & 4095, pos = wc ? (t & 63) : (t >> 6); const f32x4 cs0 = *(const f32x4*)(rope + (pos * 16 + 4 * fq) * 2), cs1 = *(const f32x4*)(rope + (pos * 16 + 4 * fq) * 2 + 4);
                            const float c_[4] = {cs0[0], cs0[2], cs1[0], cs1[2]}, s_[4] = {cs0[1], cs0[3], cs1[1], cs1[3]};
#pragma unroll
                            for (int j = 0; j < 4; ++j) { o1[j] = x1[j] * c_[j] - x2[j] * s_[j]; o2[j] = x2[j] * c_[j] + x1[j] * s_[j]; } }
                        const unsigned w1 = cvt4_fp8(o1[0], o1[1], o1[2], o1[3]), w2 = cvt4_fp8(o2[0], o2[1], o2[2], o2[3]);
                        unsigned char* kp = KB + (size_t)krow_of(row) * 1536 + 128 + wc * 32 + 4 * fq;
#pragma unroll
                        for (int h = 0; h < 8; ++h) { *(unsigned*)(kp + h * 192) = w1; *(unsigned*)(kp + h * 192 + 16) = w2; } }
            }
        } else {
            const bool isv = pn >= 9; bf16_t* O = isv ? GV : GU; const int cb = ((pn - 5) & 3) * 256 + cw;
#pragma unroll
            for (int ai = 0; ai < 2; ++ai)
#pragma unroll
                for (int m = 0; m < 4; ++m) { const int row = row0 + ai * HALF + m * 16; const float rs = rsc[row]; float s1 = 0.f, s2 = 0.f;
#pragma unroll
                    for (int bj = 0; bj < 2; ++bj) { f32x4 g0, g1; const f32x4 v0 = DQ(ai, bj, m, 0), v1 = DQ(ai, bj, m, 1);
#pragma unroll
                        for (int j = 0; j < 4; ++j) { g0[j] = gelu_tanh(v0[j]); g1[j] = gelu_tanh(v1[j]); }
                        *(u32x4*)(O + (size_t)row * 1024 + cb + bj * HALF) = pack8(g0, g1); s1 += sum4(g0) + sum4(g1); s2 += sq4(g0) + sq4(g1); }
                    if (isv) { s1 = quad_row_sum(s1); s2 = quad_row_sum(s2); if (fq == 0) { unsafeAtomicAdd(zs1 + row, s1); unsafeAtomicAdd(zs2 + row, s2); } } }
        }
#undef DQ
    }
};
struct EpiQ {
    static constexpr bool PERM = true;
    unsigned char* Q; const float* ssq_q; const float* rope;
    __device__ __forceinline__ void operator()(const AccT& acc, const Unit& u, int wr, int wc, int fr, int fq) const {
        const int row0 = u.orow0 + wr * 64 + fr;
#pragma unroll
        for (int ai = 0; ai < 2; ++ai)
#pragma unroll
            for (int m = 0; m < 4; ++m) { const int row = row0 + ai * HALF + m * 16; const float rs = __builtin_amdgcn_rsqf(ssq_q[row] * (1.0f / 512.0f) + EPS) * (QSCALE * Q8S);
                unsigned char* qp = Q + (size_t)row * 1536;
                if (u.pn < 4) {
#pragma unroll
                    for (int bj = 0; bj < 2; ++bj) { const f32x4 a0 = acc[ai][bj][m][0] * rs, a1 = acc[ai][bj][m][1] * rs; u32x2 w; w.x = cvt4_fp8(a0[0], a0[1], a0[2], a0[3]); w.y = cvt4_fp8(a1[0], a1[1], a1[2], a1[3]);
                        *(u32x2*)(qp + (2 * u.pn + bj) * 192 + wc * 32 + 8 * fq) = w; }
                } else {
                    const int t = row & 4095, ax = wc & 1, pos = ax ? (t & 63) : (t >> 6);
                    const f32x4 cs0 = *(const f32x4*)(rope + (pos * 16 + 4 * fq) * 2), cs1 = *(const f32x4*)(rope + (pos * 16 + 4 * fq) * 2 + 4);
                    const float c_[4] = {cs0[0], cs0[2], cs1[0], cs1[2]}, s_[4] = {cs0[1], cs0[3], cs1[1], cs1[3]};
#pragma unroll
                    for (int bj = 0; bj < 2; ++bj) { const int hh = 4 * (u.pn - 4) + 2 * bj + (wc >> 1); const f32x4 x1 = acc[ai][bj][m][0] * rs, x2 = acc[ai][bj][m][1] * rs; f32x4 o1, o2;
#pragma unroll
                        for (int j = 0; j < 4; ++j) { o1[j] = x1[j] * c_[j] - x2[j] * s_[j]; o2[j] = x2[j] * c_[j] + x1[j] * s_[j]; }
                        unsigned char* p = qp + hh * 192 + 128 + ax * 32 + 4 * fq; *(unsigned*)p = cvt4_fp8(o1[0], o1[1], o1[2], o1[3]); *(unsigned*)(p + 16) = cvt4_fp8(o2[0], o2[1], o2[2], o2[3]); }
                } }
    }
};
struct EpiKV {
    static constexpr bool PERM = true;
    unsigned char* KB; unsigned char* VB; const float* ssq_kv;
    __device__ __forceinline__ void operator()(const AccT& acc, const Unit& u, int wr, int wc, int fr, int fq) const {
        const int row0 = u.orow0 + wr * 64 + fr, cw = wc * 32 + 8 * fq;
#pragma unroll
        for (int ai = 0; ai < 2; ++ai)
#pragma unroll
            for (int m = 0; m < 4; ++m) { const int row = row0 + ai * HALF + m * 16; const float rs = __builtin_amdgcn_rsqf(ssq_kv[row] * (1.0f / 512.0f) + EPS); const int kr = krow_of(row);
                { const f32x4 a0 = acc[ai][0][m][0] * rs, a1 = acc[ai][0][m][1] * rs; u32x2 w; w.x = cvt4_fp8(a0[0], a0[1], a0[2], a0[3]); w.y = cvt4_fp8(a1[0], a1[1], a1[2], a1[3]); *(u32x2*)(KB + (size_t)kr * 1536 + u.pn * 192 + cw) = w; }
                { const int bb = row < ML ? (row >> 12) : ((row - ML) >> 8), key = kr - bb * KVL;
                  const unsigned vo = (unsigned)(((bb * 8 + u.pn) * 128 + cw) * KVL + (key & ~63) + v_pos(key & 63));
                  const f32x4 a0 = acc[ai][1][m][0] * rs, a1 = acc[ai][1][m][1] * rs; const unsigned w0 = cvt4_fp8(a0[0], a0[1], a0[2], a0[3]), w1 = cvt4_fp8(a1[0], a1[1], a1[2], a1[3]);
#pragma unroll
                  for (int j = 0; j < 4; ++j) { VB[vo + (unsigned)(j * KVL)] = (unsigned char)(w0 >> (8 * j)); VB[vo + (unsigned)((4 + j) * KVL)] = (unsigned char)(w1 >> (8 * j)); } } }
    }
};
struct EpiQKV {
    static constexpr bool PERM = true;
    EpiQ q; EpiKV kv;
    __device__ __forceinline__ void operator()(const AccT& acc, const Unit& u, int wr, int wc, int fr, int fq) const { if (u.g == 0) q(acc, u, wr, wc, fr, fq); else kv(acc, u, wr, wc, fr, fq); }
};
struct EpiBf16 {
    static constexpr bool PERM = true;
    bf16_t* O; int ldo; float scale;
    __device__ __forceinline__ void operator()(const AccT& acc, const Unit& u, int wr, int wc, int fr, int fq) const {
        const int row0 = u.orow0 + wr * 64 + fr, cb = u.pn * 256 + wc * 32 + 8 * fq;
#pragma unroll
        for (int ai = 0; ai < 2; ++ai)
#pragma unroll
            for (int m = 0; m < 4; ++m) { bf16_t* rp = O + (size_t)(row0 + ai * HALF + m * 16) * ldo + cb;
#pragma unroll
                for (int bj = 0; bj < 2; ++bj) *(u32x4*)(rp + bj * HALF) = pack8(acc[ai][bj][m][0] * scale, acc[ai][bj][m][1] * scale); }
    }
};
}

namespace att {
constexpr int DQK = 192, DV = 128, NW = 8, QBLK = 32, KVBLK = 64;
constexpr int LDQ = 1536, LDKK = 1536, LDVV = 1024, LDO = 2048;
constexpr float THR = 8.0f;
constexpr int KROW = 208;
constexpr int VROW = 80;
constexpr int SHM_V = DV * VROW, SHM_K = KVBLK * KROW;
constexpr int NBUF = 3;
constexpr int SHM_ATTN = NBUF * SHM_V + NBUF * SHM_K + NW * 64 * 4;
#define KSWZ(row, colB) ((row) * 384 + ((colB) ^ (((row) & 7) << 4)))
#define SBAR() __builtin_amdgcn_sched_barrier(0)
__device__ __forceinline__ int crow(int r, int hi) { return (r & 3) + 8 * (r >> 2) + 4 * hi; }
__device__ __forceinline__ unsigned cvtpk(float lo, float hi) { unsigned r; asm volatile("v_cvt_pk_bf16_f32 %0, %1, %2" : "=v"(r) : "v"(lo), "v"(hi)); return r; }
__device__ __forceinline__ void partialSM(f32x16& p0, f32x16& p1, float& m_reg, float& mn, float& alpha) {
    float pmax;
    { float ma = fmaxf(p0[0], p0[1]), mb = fmaxf(p0[8], p0[9]), mc = fmaxf(p1[0], p1[1]), md = fmaxf(p1[8], p1[9]);
#pragma unroll
      for (int r = 2; r < 8; r += 2) { ma = fmaxf(fmaxf(ma, p0[r]), p0[r + 1]); mb = fmaxf(fmaxf(mb, p0[8 + r]), p0[9 + r]); mc = fmaxf(fmaxf(mc, p1[r]), p1[r + 1]); md = fmaxf(fmaxf(md, p1[8 + r]), p1[9 + r]); }
      pmax = fmaxf(fmaxf(ma, mb), fmaxf(mc, md)); }
    { auto rr = __builtin_amdgcn_permlane32_swap(__float_as_uint(pmax), __float_as_uint(pmax), false, false);
      pmax = fmaxf(__uint_as_float(rr[0]), __uint_as_float(rr[1])); }
    if (__builtin_expect(__all(pmax - m_reg <= THR), 1)) { mn = m_reg; alpha = 1.f; }
    else { mn = fmaxf(m_reg, pmax); alpha = __builtin_amdgcn_exp2f(m_reg - mn); m_reg = mn; }
#pragma unroll
    for (int r = 0; r < 16; ++r) p0[r] = p0[r] - mn;
#pragma unroll
    for (int r = 0; r < 16; ++r) p1[r] = p1[r] - mn;
#pragma unroll
    for (int r = 0; r < 16; ++r) p0[r] = __builtin_amdgcn_exp2f(p0[r]);
}
__device__ __forceinline__ void partialSM_shift(f32x16& p0, f32x16& p1, float& m_reg, float& alpha) {
    float pmax;
    { float ma = fmaxf(p0[0], p0[1]), mb = fmaxf(p0[8], p0[9]), mc = fmaxf(p1[0], p1[1]), md = fmaxf(p1[8], p1[9]);
#pragma unroll
      for (int r = 2; r < 8; r += 2) { ma = fmaxf(fmaxf(ma, p0[r]), p0[r + 1]); mb = fmaxf(fmaxf(mb, p0[8 + r]), p0[9 + r]); mc = fmaxf(fmaxf(mc, p1[r]), p1[r + 1]); md = fmaxf(fmaxf(md, p1[8 + r]), p1[9 + r]); }
      pmax = fmaxf(fmaxf(ma, mb), fmaxf(mc, md)); }
    { auto rr = __builtin_amdgcn_permlane32_swap(__float_as_uint(pmax), __float_as_uint(pmax), false, false);
      pmax = fmaxf(__uint_as_float(rr[0]), __uint_as_float(rr[1])); }
    if (__builtin_expect(__all(pmax <= THR), 1)) { alpha = 1.f; }
    else { const float d = fmaxf(pmax, 0.f); alpha = __builtin_amdgcn_exp2f(-d); m_reg += d;
#pragma unroll
        for (int r = 0; r < 16; ++r) p0[r] = p0[r] - d;
#pragma unroll
        for (int r = 0; r < 16; ++r) p1[r] = p1[r] - d; }
#pragma unroll
    for (int r = 0; r < 16; ++r) p0[r] = __builtin_amdgcn_exp2f(p0[r]);
}
__device__ __forceinline__ void finishSM(f32x16& p0, f32x16& p1, float alpha, float& l_reg, pg8::i32x8& pa) {
#pragma unroll
    for (int r = 0; r < 16; ++r) p1[r] = __builtin_amdgcn_exp2f(p1[r]);
    float ps;
    { float sa = p0[0] + p0[1], sb = p0[8] + p0[9], sc = p1[0] + p1[1], sd = p1[8] + p1[9];
#pragma unroll
      for (int r = 2; r < 8; ++r) { sa += p0[r]; sb += p0[8 + r]; sc += p1[r]; sd += p1[8 + r]; }
      ps = (sa + sb) + (sc + sd); }
    { auto rr = __builtin_amdgcn_permlane32_swap(__float_as_uint(ps), __float_as_uint(ps), false, false);
      ps = __uint_as_float(rr[0]) + __uint_as_float(rr[1]); }
    l_reg = l_reg * alpha + ps;
#define PK8(P, B) ({ int w_ = 0; w_ = __builtin_amdgcn_cvt_pk_fp8_f32(P[B], P[B + 1], w_, false); w_ = __builtin_amdgcn_cvt_pk_fp8_f32(P[B + 2], P[B + 3], w_, true); w_; })
    pa = (pg8::i32x8){PK8(p0, 0), PK8(p0, 4), PK8(p0, 8), PK8(p0, 12), PK8(p1, 0), PK8(p1, 4), PK8(p1, 8), PK8(p1, 12)};
#undef PK8
}
__device__ __forceinline__ void qkt(f32x16& p0, f32x16& p1, const int kb, const pg8::i32x8 (&qf)[3], float minit) {
#pragma unroll
    for (int r = 0; r < 16; ++r) { p0[r] = -minit; p1[r] = -minit; }
#pragma unroll
    for (int s = 0; s < 3; ++s) {
        const u32x4 a0 = *reinterpret_cast<const LAS u32x4*>((uintptr_t)(unsigned)(kb + (s * 64))), a1 = *reinterpret_cast<const LAS u32x4*>((uintptr_t)(unsigned)(kb + (s * 64 + 16)));
        const u32x4 b0 = *reinterpret_cast<const LAS u32x4*>((uintptr_t)(unsigned)(kb + (s * 64 + 32 * KROW))), b1 = *reinterpret_cast<const LAS u32x4*>((uintptr_t)(unsigned)(kb + (s * 64 + 32 * KROW + 16)));
        const pg8::i32x8 A0 = {(int)a0.x, (int)a0.y, (int)a0.z, (int)a0.w, (int)a1.x, (int)a1.y, (int)a1.z, (int)a1.w}, A1 = {(int)b0.x, (int)b0.y, (int)b0.z, (int)b0.w, (int)b1.x, (int)b1.y, (int)b1.z, (int)b1.w};
        p0 = __builtin_amdgcn_mfma_scale_f32_32x32x64_f8f6f4(A0, qf[s], p0, 0, 0, 0, 0, 0, 0);
        p1 = __builtin_amdgcn_mfma_scale_f32_32x32x64_f8f6f4(A1, qf[s], p1, 0, 0, 0, 0, 0, 0);
    }
}
__device__ __forceinline__ void pv_d0(f32x16* o, int vb, const pg8::i32x8 pa) {
#pragma unroll
    for (int d0 = 0; d0 < 4; ++d0) {
        const u32x4 x0 = *reinterpret_cast<const LAS u32x4*>((uintptr_t)(unsigned)(vb + d0 * 32 * VROW)), x1 = *reinterpret_cast<const LAS u32x4*>((uintptr_t)(unsigned)(vb + d0 * 32 * VROW + 16));
        const pg8::i32x8 vf = {(int)x0.x, (int)x0.y, (int)x0.z, (int)x0.w, (int)x1.x, (int)x1.y, (int)x1.z, (int)x1.w};
        o[d0] = __builtin_amdgcn_mfma_scale_f32_32x32x64_f8f6f4(pa, vf, o[d0], 0, 0, 0, 0, 0, 0);
    }
}

__device__ __forceinline__ void attn_body(const unsigned char* __restrict__ Qb, const unsigned char* __restrict__ Kh, const unsigned char* __restrict__ Vh, bf16_t* __restrict__ Ob, int seq, char* lds) {
    int tid = threadIdx.x; asm volatile("" : "+v"(tid));
    const int wid = tid >> 6, lane = tid & 63, r32 = lane & 31, hi = lane >> 5;
    char* V_lds = lds; char* K_lds = lds + NBUF * SHM_V;
    float* ws = (float*)(lds + NBUF * SHM_V + NBUF * SHM_K) + wid * 64; float* li_l = ws; float* al_l = ws + 32;
    float m_reg = -1e30f, l_reg = 0; f32x16 o[4]; pg8::i32x8 qf[3];
    float zf = 0.f; asm volatile("" : "+v"(zf));
#pragma unroll
    for (int d = 0; d < 4; ++d)
#pragma unroll
        for (int r = 0; r < 16; ++r) o[d][r] = zf;
    const unsigned char* Qw = Qb + (size_t)(wid * QBLK + r32) * LDQ + hi * 32;
#pragma unroll
    for (int s3 = 0; s3 < 3; ++s3) { const u32x4 x0 = *reinterpret_cast<const u32x4*>(Qw + s3 * 64), x1 = *reinterpret_cast<const u32x4*>(Qw + s3 * 64 + 16);
        qf[s3] = (pg8::i32x8){(int)x0.x, (int)x0.y, (int)x0.z, (int)x0.w, (int)x1.x, (int)x1.y, (int)x1.z, (int)x1.w}; }
    const int vd = tid >> 2, vc = tid & 3; const unsigned vgo = (unsigned)(vd * 4352 + vc * 16); const int vlo = vd * VROW + vc * 16;
    const int id1 = tid < 256 ? tid + 512 : tid;
    const int kr0 = tid / 12, kc0 = tid % 12, kr1 = id1 / 12, kc1 = id1 % 12;
    const unsigned kgo0 = (unsigned)(kr0 * LDKK + kc0 * 16), kgo1 = (unsigned)(kr1 * LDKK + kc1 * 16); const int klo0 = kr0 * KROW + kc0 * 16, klo1 = kr1 * KROW + kc1 * 16;
    const int vb0 = (int)(uintptr_t)V_lds + r32 * VROW + hi * 32;
    const int kb = (int)(uintptr_t)K_lds + r32 * KROW + hi * 32;
    u32x4 sv0, sk0, sk1;
#define SLOAD(k0) do { sv0 = *reinterpret_cast<const u32x4*>(Vh + (size_t)(k0) + vgo); \
    const unsigned char* kp_ = Kh + (size_t)(k0) * LDKK; sk0 = *reinterpret_cast<const u32x4*>(kp_ + kgo0); sk1 = *reinterpret_cast<const u32x4*>(kp_ + kgo1); } while (0)
#define SWRITE(b) do { *(u32x4*)(V_lds + (b) * SHM_V + vlo) = sv0; \
    *(u32x4*)(K_lds + (b) * SHM_K + klo0) = sk0; *(u32x4*)(K_lds + (b) * SHM_K + klo1) = sk1; } while (0)
#define SWAIT() asm volatile("s_waitcnt vmcnt(0)" ::: "memory")
#define RESC(a) do { if (__any((a) < 1.f)) { if (hi == 0) al_l[r32] = (a); asm volatile("s_waitcnt lgkmcnt(0)" ::: "memory"); \
    _Pragma("unroll") for (int d = 0; d < 4; ++d) _Pragma("unroll") for (int r = 0; r < 16; ++r) o[d][r] *= al_l[crow(r, hi)]; } } while (0)
    f32x16 pA0, pA1, pB0, pB1; float mnA, mnB, alA, alB; pg8::i32x8 pa; const int NT = seq / KVBLK;
    const int klast = (NT - 1) * KVBLK;
    SLOAD(0); SWAIT(); SWRITE(0); SLOAD(KVBLK); __syncthreads();
    SWAIT(); SWRITE(1); SLOAD(2 * KVBLK); SBAR();
    qkt(pA0, pA1, kb, qf, zf); partialSM(pA0, pA1, m_reg, mnA, alA);
    __syncthreads();
    int bm = 0, bc = 1, bn = 2;
    for (int j = 1; j + 1 < NT; j += 2) {
        SWAIT(); SWRITE(bn); SLOAD(min((j + 2) * KVBLK, klast)); SBAR();
        qkt(pB0, pB1, kb + bc * SHM_K, qf, m_reg);
        finishSM(pA0, pA1, alA, l_reg, pa); SBAR();
        pv_d0(o, vb0 + bm * SHM_V, pa); partialSM_shift(pB0, pB1, m_reg, alB);
        RESC(alB); __syncthreads();
        SWAIT(); SWRITE(bm); SLOAD(min((j + 3) * KVBLK, klast)); SBAR();
        qkt(pA0, pA1, kb + bn * SHM_K, qf, m_reg);
        finishSM(pB0, pB1, alB, l_reg, pa); SBAR();
        pv_d0(o, vb0 + bc * SHM_V, pa); partialSM_shift(pA0, pA1, m_reg, alA);
        RESC(alA); __syncthreads();
        { const int t_ = bm; bm = bn; bn = bc; bc = t_; }
    }
    SWAIT(); SBAR();
    qkt(pB0, pB1, kb + bc * SHM_K, qf, m_reg);
    finishSM(pA0, pA1, alA, l_reg, pa); SBAR();
    pv_d0(o, vb0 + bm * SHM_V, pa); partialSM_shift(pB0, pB1, m_reg, alB);
    RESC(alB);
    finishSM(pB0, pB1, alB, l_reg, pa); SBAR();
    pv_d0(o, vb0 + bc * SHM_V, pa);
    if (hi == 0) li_l[r32] = l_reg; asm volatile("s_waitcnt lgkmcnt(0)" ::: "memory");
    int le = lane; asm volatile("" : "+v"(le));
    const int r32e = le & 31, hie = le >> 5;
    bf16_t* Ow = Ob + (size_t)(wid * QBLK) * LDO;
#pragma unroll
    for (int r = 0; r < 16; ++r) { const int orow = crow(r, hie); const float rli = __builtin_amdgcn_rcpf(li_l[orow]); const unsigned ob = (unsigned)(orow * LDO + r32e);
#pragma unroll
        for (int d0 = 0; d0 < 4; ++d0) { const unsigned w = cvtpk(o[d0][r] * rli, 0.f); Ow[ob + d0 * 32] = (bf16_t)(w & 0xffffu); } }
#undef SLOAD
#undef SWRITE
#undef SWAIT
#undef RESC
}
}

struct Params {
    const float* in[35];
    float* out; unsigned char* ws;
    int ph_lo, ph_hi, use_bar, grid;
};
constexpr int NPHASE = 17;
typedef __attribute__((address_space(1))) const float GF;
struct InTbl { GF* const* p; __device__ __forceinline__ const float* operator[](int i) const { return (const float*)p[i]; } };
struct Ctx { InTbl in; float* out; unsigned char* ws; };
__device__ __forceinline__ GF* const* in_tbl() { GF* const* p = (GF* const*)__builtin_amdgcn_kernarg_segment_ptr(); asm volatile("" : "+s"(p)); return p; }

__device__ __forceinline__ int rope_src(int p) { const int fq = p >> 3, nn = (p >> 2) & 1, jj = p & 3; return nn * 16 + 4 * fq + jj; }
struct TD { const float* p; const float* ks; unsigned char* dst; int ld; unsigned dpitch; float wscale; int fp8; const float* cm; };
constexpr int TR_I0 = 12 * 16, TR_I1 = 8 * 8, TR_I2 = 44 * 16, TR_I3 = 8 * 44, TR_I4 = 13 * 16, TR_I5 = 6 * 4, TR_I6 = 8 * 4, TR_I7 = 8 * 16, TR_I8 = 448 * 16, TR_I9 = 64 * 56;
constexpr int TR_NMAIN = TR_I0 + TR_I1 + TR_I2 + TR_I3 + TR_I4 + TR_I5 + TR_I6 + TR_I7;
constexpr int TR_NMOE = TR_I8 + TR_I9;
__device__ __forceinline__ TD tr_get(const Ctx& P, int it, int lane, int wave) {
    unsigned char* ws = P.ws;
    TD t; int r = it; const int q4 = 4 * lane, kw = 16 * wave; t.ks = nullptr; t.wscale = 1.0f; t.fp8 = 0; t.cm = nullptr;
    if (r < TR_I0) { const int n = (r % 12) * 256 + q4, k0 = (r / 12) * 128; int col;
        if (n < 1024) col = n; else { const int q = n - 1024, j = q >> 8, half = (q >> 7) & 1, w = q & 127; col = 1024 + half * 1024 + j * 128 + w; }
        t.p = P.in[8] + (size_t)(k0 + kw) * 3072 + col; t.ld = 3072; t.fp8 = 2; t.cm = (const float*)(ws + WS_CTL) + CW_CMAX_EIN + n; t.dst = ws + WS_WEIN + (size_t)(n - q4) * 2048 + k0; t.dpitch = 2048; return t; } r -= TR_I0;
    if (r < TR_I1) { const int n = (r % 8) * 256 + q4, k0 = (r / 8) * 128;
        t.p = P.in[15] + (size_t)(1024 + k0 + kw) * DM + n; t.ld = DM; t.dst = ws + WS_WEOUT + ((size_t)(n - q4) * 2048 + 1024 + k0) * 2; t.dpitch = 4096; return t; } r -= TR_I1;
    if (r < TR_I2) { const int n = (r % 44) * 256 + q4, k0 = (r / 44) * 128; const int j = n >> 8, half = (n >> 7) & 1, w = n & 127;
        t.p = (half ? P.in[17] : P.in[16]) + (size_t)(k0 + kw) * DFF + j * 128 + w; t.ld = DFF; t.fp8 = 2; t.cm = (const float*)(ws + WS_CTL) + CW_CMAX + n;
        t.dst = ws + WS_WF1 + (size_t)(n - q4) * 2048 + k0; t.dpitch = 2048; return t; } r -= TR_I2;
    if (r < TR_I3) { const int n = (r % 8) * 256 + q4, k0 = (r / 8) * 128;
        t.p = P.in[18] + (size_t)(k0 + kw) * DM + n; t.ld = DM; t.wscale = W2S; t.fp8 = 1; t.dst = ws + WS_WF2 + (size_t)(n - q4) * DFF + k0; t.dpitch = DFF; return t; } r -= TR_I3;
    if (r < TR_I4) { const int n = (r % 13) * 256 + q4, k0 = (r / 13) * 128; int col;
        if (n < 1024) col = n; else if (n < 1088) { const int p = n - 1024; col = 1024 + (p & 32) + rope_src(p & 31); } else if (n < 1280) col = -1; else col = n - 192;
        t.p = col < 0 ? nullptr : P.in[19] + (size_t)(k0 + kw) * 3136 + col; t.ld = 3136; t.fp8 = 2; t.cm = (const float*)(ws + WS_CTL) + CW_CMAX_OIN + n; t.dst = ws + WS_WOIN + (size_t)(n - q4) * 2048 + k0; t.dpitch = 2048; return t; } r -= TR_I4;
    if (r < TR_I5) { const int n = (r % 6) * 256 + q4, k0 = (r / 6) * 128; int col;
        if (n < 1024) col = (n >> 7) * 192 + (n & 127); else { const int p = n - 1024, h = p >> 6, pp = p & 63; col = h * 192 + 128 + (pp & 32) + rope_src(pp & 31); }
        t.p = P.in[21] + (size_t)(k0 + kw) * 1536 + col; t.ld = 1536; t.ks = P.in[20] + k0 + kw; t.dst = ws + WS_WQB + ((size_t)(n - q4) * 512 + k0) * 2; t.dpitch = 1024; return t; } r -= TR_I5;
    if (r < TR_I6) { const int n = (r % 8) * 256 + q4, k0 = (r / 8) * 128;
        t.p = P.in[23] + (size_t)(k0 + kw) * DM + n; t.ld = DM; t.ks = P.in[22] + k0 + kw; t.dst = ws + WS_WKVB + ((size_t)(n - q4) * 512 + k0) * 2; t.dpitch = 1024; return t; } r -= TR_I6;
    if (r < TR_I7) { const int n = (r % 8) * 256 + q4, k0 = (r / 8) * 128;
        t.p = P.in[28] + (size_t)(k0 + kw) * DM + n; t.ld = DM; t.dst = ws + WS_WOOUT + ((size_t)(n - q4) * 2048 + k0) * 2; t.dpitch = 4096; return t; } r -= TR_I7;
    if (r < TR_I8) { const int nn = (r % 448) * 256 + q4, k0 = (r / 448) * 128; const int e = nn / 14336, n = nn % 14336, j = n >> 8, half = (n >> 7) & 1, w = n & 127;
        t.p = (half ? P.in[32] : P.in[31]) + (size_t)e * DM * DFFE + (size_t)(k0 + kw) * DFFE + j * 128 + w; t.ld = DFFE; t.fp8 = 2; t.cm = (const float*)(ws + WS_MCM) + nn;
        t.dst = ws + WS_WM1 + (size_t)(nn - q4) * 2048 + k0; t.dpitch = 2048; return t; } r -= TR_I8;
    { const int nn = (r % 64) * 256 + q4, k0 = (r / 64) * 128; const int e = nn >> 11, n = nn & 2047;
        t.p = P.in[33] + (size_t)e * DFFE * DM + (size_t)(k0 + kw) * DM + n; t.ld = DM; t.wscale = W2S; t.fp8 = 1;
        t.dst = ws + WS_WM2 + (size_t)(nn - q4) * DFFE + k0; t.dpitch = DFFE; return t; }
}
template <bool POLL>
__device__ __forceinline__ int tr_run(const Ctx& P, LAS unsigned char* lds, int base, int first, int step, int j0, int nitems, unsigned* cnt, unsigned target) {
    const int tid = threadIdx.x, lane = tid & 63, wave = __builtin_amdgcn_readfirstlane(tid >> 6);
    volatile LAS unsigned* flag = (volatile LAS unsigned*)(lds + LDS_MISC + 2048);
    int j = j0;
    if (first + j * step >= nitems) return j;
    if (POLL) { if (tid == 0) flag[0] = (__hip_atomic_load(cnt, __ATOMIC_RELAXED, __HIP_MEMORY_SCOPE_AGENT) >= target) ? 1u : 0u; __syncthreads(); if (flag[0]) return j; }
    f32x4 v[16];
#define TR_LOAD(td) do { if ((td).p) { _Pragma("unroll") for (int i = 0; i < 16; ++i) v[i] = __builtin_nontemporal_load((const f32x4*)((td).p + (size_t)i * (td).ld)); } \
        else { _Pragma("unroll") for (int i = 0; i < 16; ++i) v[i] = (f32x4){0.f, 0.f, 0.f, 0.f}; } } while (0)
    TD cur = tr_get(P, base + first + j * step, lane, wave); TR_LOAD(cur);
    const int sw = lane & 7;
    for (;;) {
        unsigned pollv = 0u;
        if (POLL && tid == 0) pollv = __hip_atomic_load(cnt, __ATOMIC_RELAXED, __HIP_MEMORY_SCOPE_AGENT);
        if (cur.ks) {
#pragma unroll
            for (int i = 0; i < 16; ++i) v[i] *= cur.ks[i]; }
        if (cur.fp8 == 2) {
            const f32x4 cm4 = *(const f32x4*)cur.cm;
#pragma unroll
            for (int c = 0; c < 4; ++c) { u32x4 w; const float s_ = 127.0f / fmaxf(cm4[c], 1e-30f);
                w.x = cvt4_i8(v[0][c] * s_, v[1][c] * s_, v[2][c] * s_, v[3][c] * s_); w.y = cvt4_i8(v[4][c] * s_, v[5][c] * s_, v[6][c] * s_, v[7][c] * s_);
                w.z = cvt4_i8(v[8][c] * s_, v[9][c] * s_, v[10][c] * s_, v[11][c] * s_); w.w = cvt4_i8(v[12][c] * s_, v[13][c] * s_, v[14][c] * s_, v[15][c] * s_);
                *(LAS u32x4*)(lds + (4 * lane + c) * 128 + ((wave ^ sw) << 4)) = w; }
        } else if (cur.fp8) {
#pragma unroll
            for (int c = 0; c < 4; ++c) { u32x4 w; const float s_ = cur.wscale;
                w.x = cvt4_fp8(v[0][c] * s_, v[1][c] * s_, v[2][c] * s_, v[3][c] * s_); w.y = cvt4_fp8(v[4][c] * s_, v[5][c] * s_, v[6][c] * s_, v[7][c] * s_);
                w.z = cvt4_fp8(v[8][c] * s_, v[9][c] * s_, v[10][c] * s_, v[11][c] * s_); w.w = cvt4_fp8(v[12][c] * s_, v[13][c] * s_, v[14][c] * s_, v[15][c] * s_);
                *(LAS u32x4*)(lds + (4 * lane + c) * 128 + ((wave ^ sw) << 4)) = w; }
        } else {
#pragma unroll
            for (int c = 0; c < 4; ++c) { u32x4 w0, w1;
                w0.x = cvt_pk_bf16(v[0][c], v[1][c]); w0.y = cvt_pk_bf16(v[2][c], v[3][c]); w0.z = cvt_pk_bf16(v[4][c], v[5][c]); w0.w = cvt_pk_bf16(v[6][c], v[7][c]);
                w1.x = cvt_pk_bf16(v[8][c], v[9][c]); w1.y = cvt_pk_bf16(v[10][c], v[11][c]); w1.z = cvt_pk_bf16(v[12][c], v[13][c]); w1.w = cvt_pk_bf16(v[14][c], v[15][c]);
                *(LAS u32x4*)(lds + (4 * lane + c) * 256 + (((2 * wave) ^ sw) << 4)) = w0; *(LAS u32x4*)(lds + (4 * lane + c) * 256 + (((2 * wave + 1) ^ sw) << 4)) = w1; }
        }
        const TD done = cur; ++j;
        const bool more = (first + j * step < nitems) && !(POLL && flag[0] != 0u);
        if (more) { cur = tr_get(P, base + first + j * step, lane, wave); TR_LOAD(cur); }
        __syncthreads();
        if (done.fp8) {
#pragma unroll
            for (int q = 0; q < 4; ++q) { const int id = tid + 512 * q, n = id >> 3, ch = id & 7; const u32x4 w = *(const LAS u32x4*)(lds + n * 128 + ((ch ^ ((n >> 2) & 7)) << 4));
                *(u32x4*)(done.dst + (size_t)n * done.dpitch + ch * 16) = w; }
        } else {
#pragma unroll
            for (int q = 0; q < 8; ++q) { const int id = tid + 512 * q, n = id >> 4, ch = id & 15; const u32x4 w = *(const LAS u32x4*)(lds + n * 256 + ((ch ^ ((n >> 2) & 7)) << 4));
                *(u32x4*)(done.dst + (size_t)n * done.dpitch + ch * 16) = w; }
        }
        if (POLL && tid == 0) flag[0] = (pollv >= target) ? 1u : 0u;
        __syncthreads();
        if (!more) break;
    }
#undef TR_LOAD
    return j;
}

__device__ __forceinline__ void tr_amax(const Ctx& P, LAS unsigned char* lds, int base, int first, int step, int nN) {
    const int tid = threadIdx.x, lane = tid & 63, wave = __builtin_amdgcn_readfirstlane(tid >> 6);
    LAS float* red = (LAS float*)lds;
    for (int js = first; js < 2 * nN; js += step) { const int it = (js >= nN) ? js - nN + 8 * nN : js;
        const TD t = tr_get(P, base + it, lane, wave); f32x4 mx = (f32x4){0.f, 0.f, 0.f, 0.f};
        if (t.p) {
#pragma unroll
            for (int i = 0; i < 16; ++i) { const f32x4 v = *(const f32x4*)(t.p + (size_t)i * t.ld); mx[0] = fmaxf(mx[0], fabsf(v[0])); mx[1] = fmaxf(mx[1], fabsf(v[1])); mx[2] = fmaxf(mx[2], fabsf(v[2])); mx[3] = fmaxf(mx[3], fabsf(v[3])); } }
        *(LAS f32x4*)(red + wave * 256 + 4 * lane) = mx;
        __syncthreads();
        if (tid < 256) { float m = red[tid];
#pragma unroll
            for (int w = 1; w < 8; ++w) m = fmaxf(m, red[w * 256 + tid]);
            atomicMax((unsigned*)(t.cm - 4 * lane + tid), __float_as_uint(m * 1.3f)); }
        __syncthreads();
    }
}
__device__ __forceinline__ void tr_slack(const Ctx& P, LAS unsigned char* lds, unsigned* tilectr, unsigned* cnt, unsigned target) {
    const int tid = threadIdx.x, lane = tid & 63, wave = __builtin_amdgcn_readfirstlane(tid >> 6);
    volatile LAS int* box = (volatile LAS int*)(lds + LDS_MISC + 2048);
    int r = -1; unsigned pollv = 0u;
    if (tid == 0) { int stop0 = 0; if (cnt) stop0 = (__hip_atomic_load(cnt, __ATOMIC_RELAXED, __HIP_MEMORY_SCOPE_AGENT) >= target) ? 1 : 0;
        box[0] = stop0 ? -1 : (int)__hip_atomic_fetch_add(tilectr, 1u, __ATOMIC_RELAXED, __HIP_MEMORY_SCOPE_AGENT); box[1] = stop0; }
    __syncthreads();
    int idx = box[0], stop = box[1];
    const int sw = lane & 7;
    while (idx >= 0 && idx < TR_NMOE) {
        const TD cur = tr_get(P, TR_NMAIN + idx, lane, wave);
        f32x4 v[16];
#pragma unroll
        for (int i = 0; i < 16; ++i) v[i] = __builtin_nontemporal_load((const f32x4*)(cur.p + (size_t)i * cur.ld));
        if (tid == 0 && !stop) { r = (int)__hip_atomic_fetch_add(tilectr, 1u, __ATOMIC_RELAXED, __HIP_MEMORY_SCOPE_AGENT); if (cnt) pollv = __hip_atomic_load(cnt, __ATOMIC_RELAXED, __HIP_MEMORY_SCOPE_AGENT); }
        if (cur.fp8 == 2) {
            const f32x4 cm4 = *(const f32x4*)cur.cm;
#pragma unroll
            for (int c = 0; c < 4; ++c) { u32x4 w; const float s_ = 127.0f / cm4[c];
                w.x = cvt4_i8(v[0][c] * s_, v[1][c] * s_, v[2][c] * s_, v[3][c] * s_); w.y = cvt4_i8(v[4][c] * s_, v[5][c] * s_, v[6][c] * s_, v[7][c] * s_);
                w.z = cvt4_i8(v[8][c] * s_, v[9][c] * s_, v[10][c] * s_, v[11][c] * s_); w.w = cvt4_i8(v[12][c] * s_, v[13][c] * s_, v[14][c] * s_, v[15][c] * s_);
                *(LAS u32x4*)(lds + (4 * lane + c) * 128 + ((wave ^ sw) << 4)) = w; }
        } else {
#pragma unroll
        for (int c = 0; c < 4; ++c) { u32x4 w; const float s_ = cur.wscale;
            w.x = cvt4_fp8(v[0][c] * s_, v[1][c] * s_, v[2][c] * s_, v[3][c] * s_); w.y = cvt4_fp8(v[4][c] * s_, v[5][c] * s_, v[6][c] * s_, v[7][c] * s_);
            w.z = cvt4_fp8(v[8][c] * s_, v[9][c] * s_, v[10][c] * s_, v[11][c] * s_); w.w = cvt4_fp8(v[12][c] * s_, v[13][c] * s_, v[14][c] * s_, v[15][c] * s_);
            *(LAS u32x4*)(lds + (4 * lane + c) * 128 + ((wave ^ sw) << 4)) = w; } }
        __syncthreads();
#pragma unroll
        for (int q = 0; q < 4; ++q) { const int id = tid + 512 * q, n = id >> 3, ch = id & 7; const u32x4 w = *(const LAS u32x4*)(lds + n * 128 + ((ch ^ ((n >> 2) & 7)) << 4));
            __builtin_nontemporal_store(w, (u32x4*)(cur.dst + (size_t)n * cur.dpitch + ch * 16)); }
        if (tid == 0) { box[0] = stop ? -1 : r; box[1] = stop ? 1 : ((cnt && pollv >= target) ? 1 : 0); }
        __syncthreads();
        idx = box[0]; stop = box[1];
    }
    __syncthreads();
}
template <int MODE>
__device__ __forceinline__ void phase_prologue(const Ctx& P, LAS unsigned char* lds, int vcu, int G) {
    const int tid = threadIdx.x, lane = tid & 63, wave = __builtin_amdgcn_readfirstlane(tid >> 6);
    unsigned char* ws = P.ws;
    auto fold_pool = [&]() { const int gw = vcu * 8 + wave, NGW = G * 8;
    LAS float* pwl = (LAS float*)(lds + wave * 8192);
    __syncthreads();
    for (int it = gw; it < 32 * 4 * 32; it += NGW) {
        const int nb = it & 31, g = (it >> 5) & 3, cblk = it >> 7; const int n = nb * 64 + lane, c0 = cblk * 8;
        const float* wo = P.in[15] + (size_t)(g * 256) * DM + n; const float* pw = P.in[9] + ((size_t)g * 256 + c0) * 256; const float* scl = P.in[10] + g * 256;
        { const f32x4 s4 = *(const f32x4*)(scl + 4 * lane);
#pragma unroll
          for (int q = 0; q < 8; ++q) *(LAS f32x4*)(pwl + q * 256 + 4 * lane) = *(const f32x4*)(pw + q * 256 + 4 * lane) * s4; }
        asm volatile("s_waitcnt lgkmcnt(0)" ::: "memory");
        float a[8];
#pragma unroll
        for (int cc = 0; cc < 8; ++cc) a[cc] = 0.f;
#pragma unroll 4
        for (int d4 = 0; d4 < 64; ++d4) { const f32x4 wv = (f32x4){wo[(size_t)(4 * d4) * DM], wo[(size_t)(4 * d4 + 1) * DM], wo[(size_t)(4 * d4 + 2) * DM], wo[(size_t)(4 * d4 + 3) * DM]};
#pragma unroll
            for (int cc = 0; cc < 8; ++cc) { const f32x4 p4 = *(const LAS f32x4*)(pwl + cc * 256 + 4 * d4); a[cc] += (p4[0] * wv[0] + p4[1] * wv[1]) + (p4[2] * wv[2] + p4[3] * wv[3]); } }
        u32x4 w; w.x = cvt_pk_bf16(a[0], a[1]); w.y = cvt_pk_bf16(a[2], a[3]); w.z = cvt_pk_bf16(a[4], a[5]); w.w = cvt_pk_bf16(a[6], a[7]);
        *(u32x4*)((bf16_t*)(ws + WS_WEOUT) + (size_t)n * DM + g * 256 + c0) = w;
        asm volatile("s_waitcnt lgkmcnt(0)" ::: "memory");
    }
    __syncthreads();
    };
    if constexpr (MODE == 0) {
    {
        LAS float* sS = (LAS float*)lds;
        LAS float* red = (LAS float*)(lds + 65536);
        for (int i = tid; i < 5 * DM; i += 512) { const int r = i / DM, k = i % DM; const float cv = r < 4 ? P.in[1][r * DM + k] : P.in[3][k]; sS[i] = siluf_(cv); }
        __syncthreads();
        for (int blk = vcu; blk < 256; blk += G) {
            const int layer = blk >> 7, cb = (blk & 127) * 96;
            const float* W = P.in[4] + (size_t)layer * DM * NMOD;
            const int cg = lane & 31, ks = lane >> 5; const bool act = cg < 24;
            f32x4 a[5];
#pragma unroll
            for (int r = 0; r < 5; ++r) a[r] = (f32x4){0.f, 0.f, 0.f, 0.f};
            if (act) {
                const float* wp = W + (size_t)(wave * 256 + ks) * NMOD + cb + 4 * cg;
#pragma unroll 8
                for (int i = 0; i < 128; ++i) { const f32x4 w = __builtin_nontemporal_load((const f32x4*)(wp + (size_t)(2 * i) * NMOD)); const int k = wave * 256 + 2 * i + ks;
#pragma unroll
                    for (int r = 0; r < 5; ++r) a[r] += w * sS[r * DM + k]; }
            }
#pragma unroll
            for (int r = 0; r < 5; ++r)
#pragma unroll
                for (int j = 0; j < 4; ++j) a[r][j] += __shfl_xor(a[r][j], 32);
            if (act && ks == 0) {
#pragma unroll
                for (int r = 0; r < 5; ++r)
#pragma unroll
                    for (int j = 0; j < 4; ++j) red[(wave * 5 + r) * 96 + 4 * cg + j] = a[r][j]; }
            __syncthreads();
            if (tid < 480) { const int r = tid / 96, cc = tid % 96; float s = 0.f;
#pragma unroll
                for (int w = 0; w < 8; ++w) s += red[(w * 5 + r) * 96 + cc];
                ((float*)(ws + WS_MOD))[((size_t)layer * 5 + r) * NMOD + cb + cc] = s + P.in[5][(size_t)layer * NMOD + cb + cc]; }
            __syncthreads();
        }
    }
    const int gw = vcu * 8 + wave, NGW = G * 8;
    if (gw == 0) { for (int i = lane; i < 1024; i += 64) { const int pos = i >> 4, f = i & 15; const float inv = exp2f(-(float)f * (13.287712379549449f / 16.0f)); float s, c; sincosf((float)pos * inv, &s, &c);
        ((float*)(ws + WS_ROPE))[2 * i] = c; ((float*)(ws + WS_ROPE))[2 * i + 1] = s; } }
    for (int i = gw * 64 + lane; i < 8 * 128 * 128 / 4; i += NGW * 64) { const f32x4 v = *(const f32x4*)(P.in[26] + 4 * (size_t)i); u32x2 w; w.x = cvt_pk_bf16(v[0], v[1]); w.y = cvt_pk_bf16(v[2], v[3]); *(u32x2*)(ws + WS_WSGU + 8 * (size_t)i) = w; }
    if (!(vcu & 1)) fold_pool();
    }
#ifndef PROBE_NWG
#define PROBE_NWG 128
#endif
    if (MODE == 1 && (int)blockIdx.x >= PROBE_NWG) return;
    const int f0 = MODE == 0 ? vcu : (int)blockIdx.x, st = MODE == 0 ? G : PROBE_NWG;
    const int f1 = MODE == 0 ? (vcu + G - 64 % G) % G : f0, f2 = MODE == 0 ? (vcu + 2 * G - (64 + 352) % G) % G : f0;
    (void)tr_run<false>(P, lds, TR_I0, f0, st, 0, TR_I1, nullptr, 0u);
    (void)tr_run<false>(P, lds, TR_I0 + TR_I1 + TR_I2, f1, st, 0, TR_I3, nullptr, 0u);
    (void)tr_run<false>(P, lds, TR_I0 + TR_I1 + TR_I2 + TR_I3 + TR_I4, f2, st, 0, TR_I5 + TR_I6 + TR_I7, nullptr, 0u);
    if constexpr (MODE == 0) {
        tr_amax(P, lds, 0, (vcu + 3 * G - 600 % G) % G, G, 12);
        tr_amax(P, lds, TR_I0 + TR_I1, (vcu + 3 * G - 624 % G) % G, G, 44);
        tr_amax(P, lds, TR_I0 + TR_I1 + TR_I2 + TR_I3, (vcu + 3 * G - 712 % G) % G, G, 13);
        { const int wave_g = vcu * 8 + wave;
          for (int rr = wave_g; rr < 16 * 32; rr += G * 8) { const int tsr = rr >> 5, e = tsr >> 1, half = tsr & 1, kr = (rr & 31) * 64 + 29;
              const float* src = (half ? P.in[32] : P.in[31]) + (size_t)e * DM * DFFE + (size_t)kr * DFFE; float m = 0.f;
#pragma unroll 7
              for (int c = lane * 4; c < DFFE; c += 256) { const f32x4 v4 = __builtin_nontemporal_load((const f32x4*)(src + c)); m = fmaxf(m, fmaxf(fmaxf(fabsf(v4[0]), fabsf(v4[1])), fmaxf(fabsf(v4[2]), fabsf(v4[3])))); }
#pragma unroll
              for (int o = 1; o < 64; o <<= 1) m = fmaxf(m, __shfl_xor(m, o));
              if (lane == 0) atomicMax((unsigned*)(P.ws + WS_CTL) + CW_MOEMAX + tsr, __float_as_uint(m)); } }
        if (vcu & 1) fold_pool();
    }
}

template <int SRC, int CTXP = 0, bool OUTI8 = false>
__device__ __forceinline__ void phase_norm(const Ctx& P, int layer, int nrows, const float* gvec, int shc, int scc, int vcu, int G) {
    const int tid = threadIdx.x, lane = tid & 63, wave = __builtin_amdgcn_readfirstlane(tid >> 6);
    const int gw = vcu * 8 + wave, NGW = G * 8;
    const float* mod = (const float*)(P.ws + WS_MOD) + (size_t)layer * 5 * NMOD;
    bf16_t* HN = (bf16_t*)(P.ws + WS_HN);
    for (int row = gw; row < nrows; row += NGW) {
        const float* xr = row < ML ? P.in[0] + (size_t)row * DM : P.in[2] + (size_t)(row - ML) * DM;
        const bf16_t* xb = (const bf16_t*)(P.ws + WS_XA) + (size_t)row * DM;
        const int cnd = cond_of(row);
        f32x4 v[8]; float ss = 0.f;
#pragma unroll
        for (int j = 0; j < 8; ++j) v[j] = (SRC == 0) ? *(const f32x4*)(xr + 4 * lane + 256 * j) : ld4_bf(xb + 4 * lane + 256 * j);
        if (CTXP != 0 && row >= ML) {
            const float* pp = (const float*)(P.ws + WS_PART) + (size_t)(row - ML) * DM; const float* xc = P.in[2] + (size_t)(row - ML) * DM;
#pragma unroll
            for (int j = 0; j < 8; ++j) { const int c = 4 * lane + 256 * j; if (CTXP == 1) v[j] = *(const f32x4*)(xc + c);
#pragma unroll
                for (int p = 0; p < (CTXP == 1 ? 4 : 2); ++p) v[j] += *(const f32x4*)(pp + (size_t)p * MC * DM + c);
                if (CTXP == 1) st4_bf((bf16_t*)(P.ws + WS_XA) + (size_t)row * DM + c, v[j]); }
        }
#pragma unroll
        for (int j = 0; j < 8; ++j) ss += sq4(v[j]);
        ss = wave_sum(ss); const float rstd = __builtin_amdgcn_rsqf(ss * (1.0f / DM) + EPS);
        const float* shp = mod + (size_t)cnd * NMOD + shc * DM; const float* scp = mod + (size_t)cnd * NMOD + scc * DM;
        if constexpr (OUTI8) {
            float amax = 0.f;
#pragma unroll
            for (int j = 0; j < 8; ++j) { const int c = 4 * lane + 256 * j; const f32x4 g4 = *(const f32x4*)(gvec + c), sc4 = *(const f32x4*)(scp + c), sh4 = *(const f32x4*)(shp + c);
                v[j] = v[j] * rstd * g4 * (sc4 + 1.0f) + sh4; amax = fmaxf(amax, fmaxf(fmaxf(fabsf(v[j][0]), fabsf(v[j][1])), fmaxf(fabsf(v[j][2]), fabsf(v[j][3])))); }
#pragma unroll
            for (int o = 1; o < 64; o <<= 1) amax = fmaxf(amax, __shfl_xor(amax, o));
            amax = fmaxf(amax, 1e-30f); const float qs = 127.0f / amax;
            if (lane == 0) ((float*)(P.ws + WS_RSC))[row] = amax * (1.0f / 127.0f);
#pragma unroll
            for (int j = 0; j < 8; ++j) *(unsigned*)((unsigned char*)HN + (size_t)row * DM + 4 * lane + 256 * j) = cvt4_i8(v[j][0] * qs, v[j][1] * qs, v[j][2] * qs, v[j][3] * qs);
        } else {
#pragma unroll
        for (int j = 0; j < 8; ++j) { const int c = 4 * lane + 256 * j; const f32x4 g4 = *(const f32x4*)(gvec + c), sc4 = *(const f32x4*)(scp + c), sh4 = *(const f32x4*)(shp + c);
            const f32x4 h = v[j] * rstd * g4 * (sc4 + 1.0f) + sh4; u32x2 w; w.x = cvt_pk_bf16(h[0], h[1]); w.y = cvt_pk_bf16(h[2], h[3]);
            *(u32x2*)(HN + (size_t)row * DM + c) = w; }
        }
    }
}

template <int W>
__device__ __forceinline__ void pool_tile(const bf16_t* __restrict__ U, bf16_t* __restrict__ Y0, int rowbase, int L, int t0, int c0) {
    f32x2 uu[32 + W - 1];
#pragma unroll
    for (int q = 0; q < 32 + W - 1; ++q) { const int j = t0 - W / 2 + q; unsigned w = 0u; if (j >= 0 && j < L) w = *(const unsigned*)(U + (size_t)(rowbase + j) * 1024 + c0); uu[q] = (f32x2){bf_lo(w), bf_hi(w)}; }
#pragma unroll
    for (int tt = 0; tt < 32; ++tt) { f32x2 s = uu[tt];
#pragma unroll
        for (int q = 1; q < W; ++q) s += uu[tt + q];
        const int t = t0 + tt; const int lo = t - W / 2 < 0 ? 0 : t - W / 2; const int hi = t - W / 2 + W > L ? L : t - W / 2 + W;
        const float inv = 1.0f / (float)(hi - lo); const f32x2 pl = s * inv - uu[tt + W / 2];
        *(unsigned*)(Y0 + (size_t)(rowbase + t) * DM + c0) = cvt_pk_bf16(pl[0], pl[1]); }
}
__device__ __forceinline__ void phase_convpool(const Ctx& P, LAS unsigned char* lds, int vcu, int G) {
    const int tid = threadIdx.x, lane = tid & 63, wave = __builtin_amdgcn_readfirstlane(tid >> 6);
    const bf16_t* U = (const bf16_t*)(P.ws + WS_U); const bf16_t* Z = (const bf16_t*)(P.ws + WS_Z); bf16_t* Y0 = (bf16_t*)(P.ws + WS_Y0);
    LAS float* tile = (LAS float*)lds;
    const int c0 = 2 * tid;
    f32x2 wk[31];
#pragma unroll
    for (int k = 0; k < 31; ++k) wk[k] = *(const f32x2*)(P.in[11] + (size_t)k * 1024 + c0);
    const f32x2 cb = *(const f32x2*)(P.in[12] + c0);
    constexpr int NU = 4 * 128 + 4 * 8;
    for (int un = vcu; un < NU; un += G) {
        int rowbase, L, t0;
        if (un < 512) { rowbase = (un >> 7) * SEQ; L = SEQ; t0 = (un & 127) * 32; } else { const int q = un - 512; rowbase = ML + (q >> 3) * CTXL; L = CTXL; t0 = (q & 7) * 32; }
        const int grp = wave >> 1;
        if (grp == 0) pool_tile<2>(U, Y0, rowbase, L, t0, c0); else if (grp == 1) pool_tile<4>(U, Y0, rowbase, L, t0, c0); else if (grp == 2) pool_tile<8>(U, Y0, rowbase, L, t0, c0); else pool_tile<16>(U, Y0, rowbase, L, t0, c0);
        {
            f32x2 zr[62];
#pragma unroll
            for (int q = 0; q < 62; ++q) { const int j = t0 - 15 + q; unsigned w = 0u; if (j >= 0 && j < L) w = *(const unsigned*)(Z + (size_t)(rowbase + j) * 1024 + c0); zr[q] = (f32x2){bf_lo(w), bf_hi(w)}; }
#pragma unroll
            for (int tt = 0; tt < 32; ++tt) { f32x2 a = cb;
#pragma unroll
                for (int k = 0; k < 31; ++k) a += wk[k] * zr[tt + k];
                *(LAS f32x2*)(tile + tt * 1024 + c0) = a; }
        }
        __syncthreads();
#pragma unroll
        for (int q = 0; q < 4; ++q) { const int tt = wave * 4 + q; f32x4 v[4]; float s = 0.f;
#pragma unroll
            for (int j = 0; j < 4; ++j) { v[j] = *(const LAS f32x4*)(tile + tt * 1024 + 4 * lane + 256 * j); s += sum4(v[j]); }
            const float mean = wave_sum(s) * (1.0f / 1024.0f); float s2 = 0.f;
#pragma unroll
            for (int j = 0; j < 4; ++j) { v[j] = v[j] - mean; s2 += sq4(v[j]); }
            const float rstd = __builtin_amdgcn_rsqf(wave_sum(s2) * (1.0f / 1024.0f) + EPS);
#pragma unroll
            for (int j = 0; j < 4; ++j) { const int c = 4 * lane + 256 * j; const f32x4 g4 = *(const f32x4*)(P.in[13] + c), b4 = *(const f32x4*)(P.in[14] + c); f32x4 y = v[j] * rstd * g4 + b4;
#pragma unroll
                for (int e = 0; e < 4; ++e) y[e] = siluf_(y[e]);
                u32x2 w; w.x = cvt_pk_bf16(y[0], y[1]); w.y = cvt_pk_bf16(y[2], y[3]); *(u32x2*)(Y0 + (size_t)(rowbase + t0 + tt) * DM + 1024 + c) = w; } }
        __syncthreads();
    }
}

__device__ __forceinline__ void phase_sgu(const Ctx& P, LAS unsigned char* lds, int vcu, int G) {
    const int tid = threadIdx.x, lane = tid & 63, wave = __builtin_amdgcn_readfirstlane(tid >> 6), fr = lane & 15, fq = lane >> 4;
    const bf16_t* GU = (const bf16_t*)(P.ws + WS_GU); const bf16_t* GV = (const bf16_t*)(P.ws + WS_GV); const bf16_t* WS_ = (const bf16_t*)(P.ws + WS_WSGU); bf16_t* CAT = (bf16_t*)(P.ws + WS_Y0);
    const float* zs1 = (const float*)(P.ws + WS_CTL) + CW_ZS1; const float* zs2 = (const float*)(P.ws + WS_CTL) + CW_ZS2;
    constexpr int VS = 272;
    for (int un = vcu; un < 4 * 32 * 8; un += G) {
        const int h = un & 7, ch = un >> 3; const int r0 = ch * 128;
#pragma unroll
        for (int q = 0; q < 4; ++q) { const int id = tid + 512 * q, j = id & 127, dc = (id >> 7) * 8; const int row = r0 + j;
            const float mean = zs1[row] * (1.0f / 1024.0f); const float var = zs2[row] * (1.0f / 1024.0f) - mean * mean; const float rstd = __builtin_amdgcn_rsqf(var + EPS);
            const u32x4 raw = *(const u32x4*)(GV + (size_t)row * 1024 + h * 128 + dc);
            const f32x4 g0 = *(const f32x4*)(P.in[24] + h * 128 + dc), g1 = *(const f32x4*)(P.in[24] + h * 128 + dc + 4), b0 = *(const f32x4*)(P.in[25] + h * 128 + dc), b1 = *(const f32x4*)(P.in[25] + h * 128 + dc + 4);
            const float x[8] = {bf_lo(raw.x), bf_hi(raw.x), bf_lo(raw.y), bf_hi(raw.y), bf_lo(raw.z), bf_hi(raw.z), bf_lo(raw.w), bf_hi(raw.w)};
            const float gg[8] = {g0[0], g0[1], g0[2], g0[3], g1[0], g1[1], g1[2], g1[3]}, bb[8] = {b0[0], b0[1], b0[2], b0[3], b1[0], b1[1], b1[2], b1[3]};
#pragma unroll
            for (int e = 0; e < 8; ++e) { const float y = (x[e] - mean) * rstd * gg[e] + bb[e]; *(LAS bf16_t*)(lds + (dc + e) * VS + j * 2) = (bf16_t)(cvt_pk_bf16(y, 0.f) & 0xffffu); } }
        __syncthreads();
        const int i0 = wave * 16;
        bf16x8 af[4];
#pragma unroll
        for (int kk = 0; kk < 4; ++kk) af[kk] = *(const bf16x8*)(WS_ + (size_t)(h * 128 + i0 + fr) * 128 + kk * 32 + fq * 8);
        const float bias = P.in[27][h * 128 + i0 + fr]; const int orow = r0 + i0 + fr;
#pragma unroll
        for (int nb = 0; nb < 8; ++nb) { f32x4 acc = (f32x4){0.f, 0.f, 0.f, 0.f};
#pragma unroll
            for (int kk = 0; kk < 4; ++kk) { const bf16x8 bfr = *(const LAS bf16x8*)(lds + (nb * 16 + fr) * VS + (kk * 32 + fq * 8) * 2); acc = __builtin_amdgcn_mfma_f32_16x16x32_bf16(bfr, af[kk], acc, 0, 0, 0); }
            const int d = nb * 16 + 4 * fq; const u32x2 gu = *(const u32x2*)(GU + (size_t)orow * 1024 + h * 128 + d);
            const float o0 = bf_lo(gu.x) * (acc[0] + bias), o1 = bf_hi(gu.x) * (acc[1] + bias), o2 = bf_lo(gu.y) * (acc[2] + bias), o3 = bf_hi(gu.y) * (acc[3] + bias);
            u32x2 w; w.x = cvt_pk_bf16(o0, o1); w.y = cvt_pk_bf16(o2, o3); *(u32x2*)(CAT + (size_t)orow * DM + 1024 + h * 128 + d) = w; }
        __syncthreads();
    }
}

__device__ __forceinline__ void phase_router(const Ctx& P, LAS unsigned char* lds, int vcu, int G) {
    const int tid = threadIdx.x, lane = tid & 63, wave = __builtin_amdgcn_readfirstlane(tid >> 6);
    LAS float* rwT = (LAS float*)lds;
    LAS unsigned char* rows8 = lds + 65536;
    LAS int* sel = (LAS int*)(lds + LDS_MISC + 1024);
    LAS float* prb = (LAS float*)(lds + LDS_MISC + 1024 + 256);
    LAS int* lrank = (LAS int*)(lds + LDS_MISC + 1024 + 512);
    LAS int* lcnt = (LAS int*)(lds + LDS_MISC + 1024 + 768);
    LAS int* lbase = (LAS int*)(lds + LDS_MISC + 1024 + 832);
    LAS float* rscl = (LAS float*)(lds + LDS_MISC + 1024 + 864);
    for (int i = tid; i < DM * 8; i += 512) { const int k = i >> 3, e = i & 7; rwT[e * DM + k] = P.in[29][i]; }
    __syncthreads();
    const float* mod = (const float*)(P.ws + WS_MOD) + (size_t)5 * NMOD;
    const float* gvec = P.in[7] + DM;
    unsigned char* HNP = P.ws + WS_HNP; unsigned* ecnt = (unsigned*)(P.ws + WS_CTL) + CW_ECNT; int* tok = (int*)(P.ws + WS_TOK);
    for (int blk = vcu; blk < ML / 32; blk += G) {
        if (tid < 8) lcnt[tid] = 0;
        for (int q = 0; q < 4; ++q) {
            const int lr = wave * 4 + q, row = blk * 32 + lr; const int cnd = row >> 12;
            const bf16_t* xr = (const bf16_t*)(P.ws + WS_XA) + (size_t)row * DM;
            f32x4 v[8]; float ss = 0.f;
#pragma unroll
            for (int j = 0; j < 8; ++j) { v[j] = ld4_bf(xr + 4 * lane + 256 * j); ss += sq4(v[j]); }
            ss = wave_sum(ss); const float rstd = __builtin_amdgcn_rsqf(ss * (1.0f / DM) + EPS);
            const float* shp = mod + (size_t)cnd * NMOD + 3 * DM; const float* scp = mod + (size_t)cnd * NMOD + 4 * DM;
            float lg[8]; float amax = 0.f;
#pragma unroll
            for (int e = 0; e < 8; ++e) lg[e] = 0.f;
#pragma unroll
            for (int j = 0; j < 8; ++j) { const int c = 4 * lane + 256 * j; const f32x4 g4 = *(const f32x4*)(gvec + c), sc4 = *(const f32x4*)(scp + c), sh4 = *(const f32x4*)(shp + c);
                const f32x4 h = v[j] * rstd * g4 * (sc4 + 1.0f) + sh4;
                amax = fmaxf(amax, fmaxf(fmaxf(fabsf(h[0]), fabsf(h[1])), fmaxf(fabsf(h[2]), fabsf(h[3]))));
#pragma unroll
                for (int e = 0; e < 8; ++e) { const f32x4 rw = *(const LAS f32x4*)(rwT + e * DM + c); lg[e] += (h[0] * rw[0] + h[1] * rw[1]) + (h[2] * rw[2] + h[3] * rw[3]); } }
#pragma unroll
            for (int e = 0; e < 8; ++e) lg[e] = wave_sum(lg[e]) + P.in[30][e];
#pragma unroll
            for (int o = 1; o < 64; o <<= 1) amax = fmaxf(amax, __shfl_xor(amax, o));
            amax = fmaxf(amax, 1e-30f);
            if (lane == 0) rscl[lr] = amax * (1.0f / 127.0f);
            { const float qs = 127.0f / amax; int l2 = lane; asm volatile("" : "+v"(l2));
#pragma unroll 2
              for (int j = 0; j < 8; ++j) { const int c = 4 * l2 + 256 * j; const f32x4 x4 = ld4_bf(xr + c), g4 = *(const f32x4*)(gvec + c), sc4 = *(const f32x4*)(scp + c), sh4 = *(const f32x4*)(shp + c);
                  const f32x4 h = (x4 * rstd * g4 * (sc4 + 1.0f) + sh4) * qs; *(LAS unsigned*)(rows8 + lr * DM + c) = cvt4_i8(h[0], h[1], h[2], h[3]); } }
            int i1 = 0; float v1 = lg[0];
#pragma unroll
            for (int e = 1; e < 8; ++e) if (lg[e] > v1) { v1 = lg[e]; i1 = e; }
            int i2 = -1; float v2 = -3.0e38f;
#pragma unroll
            for (int e = 0; e < 8; ++e) if (e != i1 && lg[e] > v2) { v2 = lg[e]; i2 = e; }
            const float p1 = 1.0f / (1.0f + __expf(v2 - v1));
            if (lane == 0) { sel[lr * 2] = i1; sel[lr * 2 + 1] = i2; prb[lr * 2] = p1; prb[lr * 2 + 1] = 1.0f - p1; }
        }
        __syncthreads();
        if (tid < 64) lrank[tid] = atomicAdd((int*)&lcnt[sel[tid]], 1);
        __syncthreads();
        if (tid < 8) lbase[tid] = (int)atomicAdd(ecnt + 64 * tid, (unsigned)lcnt[tid]);
        __syncthreads();
        if (tid < 64) { const int lr = tid >> 1, which = tid & 1, e = sel[tid], pos = lbase[e] + lrank[tid], row = blk * 32 + lr;
            tok[row * 8 + which * 2] = e; tok[row * 8 + which * 2 + 1] = pos; ((float*)tok)[row * 8 + 4 + which] = prb[tid]; }
#pragma unroll
        for (int q = 0; q < 4; ++q) { const int lr = wave * 4 + q; const u32x4 d0 = *(const LAS u32x4*)(rows8 + lr * DM + lane * 16), d1 = *(const LAS u32x4*)(rows8 + lr * DM + 1024 + lane * 16);
#pragma unroll
            for (int which = 0; which < 2; ++which) { const int e = sel[lr * 2 + which], pos = lbase[e] + lrank[lr * 2 + which]; unsigned char* dst = HNP + ((size_t)e * ML + pos) * DM;
                *(u32x4*)(dst + lane * 16) = d0; *(u32x4*)(dst + 1024 + lane * 16) = d1; if (lane == 0) ((float*)(P.ws + WS_MRS))[(size_t)e * ML + pos] = rscl[lr]; } }
        __syncthreads();
    }
}
__device__ __forceinline__ void moe_tables(const Ctx& P, volatile LAS int* tab, int nN) {
    if (tid_opaque() == 0) { const unsigned* ecnt = (const unsigned*)(P.ws + WS_CTL) + CW_ECNT; int pb = 0, cu = 0;
        for (int e = 0; e < 8; ++e) { const int c = (int)ecnt[64 * e], np = (c + 255) >> 8; tab[e] = c; tab[8 + e] = pb; tab[16 + e] = cu; pb += np; cu += np * nN; }
        tab[24] = cu; }
    __syncthreads();
}

__device__ __forceinline__ void phase_final(const Ctx& P, volatile LAS int* tab, int vcu, int G) {
    const int tid = threadIdx.x, lane = tid & 63, wave = __builtin_amdgcn_readfirstlane(tid >> 6);
    const int gw = vcu * 8 + wave, NGW = G * 8;
    const float* mod = (const float*)(P.ws + WS_MOD) + (size_t)5 * NMOD; const int* tok = (const int*)(P.ws + WS_TOK); const bf16_t* YB = (const bf16_t*)(P.ws + WS_YB);
    for (int row = gw; row < ML; row += NGW) {
        const int e1 = tok[row * 8], pos1 = tok[row * 8 + 1], e2 = tok[row * 8 + 2], pos2 = tok[row * 8 + 3]; const float p1 = ((const float*)tok)[row * 8 + 4], p2 = ((const float*)tok)[row * 8 + 5];
        const bf16_t* y1 = YB + (size_t)(tab[8 + e1] * 256 + pos1) * DM; const bf16_t* y2 = YB + (size_t)(tab[8 + e2] * 256 + pos2) * DM;
        const bf16_t* xr = (const bf16_t*)(P.ws + WS_XA) + (size_t)row * DM; const float* g2 = mod + (size_t)(row >> 12) * NMOD + 5 * DM;
        f32x4 v[8]; float ss = 0.f;
#pragma unroll
        for (int j = 0; j < 8; ++j) { const int c = 4 * lane + 256 * j; const f32x4 x4 = ld4_bf(xr + c), g4 = *(const f32x4*)(g2 + c); const u32x2 a = *(const u32x2*)(y1 + c), b = *(const u32x2*)(y2 + c);
            const f32x4 ya = (f32x4){bf_lo(a.x), bf_hi(a.x), bf_lo(a.y), bf_hi(a.y)}, yb = (f32x4){bf_lo(b.x), bf_hi(b.x), bf_lo(b.y), bf_hi(b.y)};
            v[j] = x4 + g4 * (ya * p1 + yb * p2); ss += sq4(v[j]); }
        ss = wave_sum(ss); const float rstd = __builtin_amdgcn_rsqf(ss * (1.0f / DM) + EPS);
#pragma unroll
        for (int j = 0; j < 8; ++j) { const int c = 4 * lane + 256 * j; const f32x4 fg = *(const f32x4*)(P.in[34] + c); *(f32x4*)(P.out + (size_t)row * DM + c) = v[j] * rstd * fg; }
    }
}

__global__ void __launch_bounds__(512, 2) fwd_kernel(Params KP) {
    extern __shared__ __attribute__((aligned(16))) unsigned char lds_raw[];
    LAS unsigned char* lds = (LAS unsigned char*)lds_raw;
    volatile LAS unsigned* MISC = (volatile LAS unsigned*)(lds + LDS_MISC);
    volatile LAS int* tab = (volatile LAS int*)(lds + LDS_MISC + 256);
    const int G = KP.grid; const int bx = blockIdx.x; const int vcu = (G % 8 == 0) ? (bx % 8) * (G / 8) + bx / 8 : bx;
    unsigned char* ws = KP.ws;
    for (int u = threadIdx.x; u < (LDS_BYTES - LDS_MISC) / 4; u += 512) MISC[u] = 0u;
    __syncthreads();
    if (KP.use_bar && tid_opaque() == 0) (void)xb_add((unsigned*)(ws + WS_CTL) + CW_BAR + XB_XCNT(xb_xcc_id()), 1u);
#define KARG_I(member) (((const int*)in_tbl())[offsetof(Params, member) / 4])
#define MKCTX() const Ctx P{InTbl{in_tbl()}, (float*)*(__attribute__((address_space(1))) float* const*)((const char*)in_tbl() + offsetof(Params, out)), ws}
#ifndef PH_MASK
#define PH_MASK 0x1FFFF
#endif
#define IN(k) (((PH_MASK >> (k)) & 1) && KARG_I(ph_lo) <= (k) && (k) < KARG_I(ph_hi))
#define SEAM(k) do { if (IN(k) && IN((k) + 1)) { XcdBarrier bar_; bar_.bar = (unsigned*)(ws + WS_CTL) + CW_BAR; bar_.x = xb_xcc_id(); bar_.st = MISC + 8; bar_.G = (unsigned)KARG_I(grid); xcd_barrier(bar_); } } while (0)
    float* ctlf = (float*)(ws + WS_CTL);
#define SLACK(k) do { __syncthreads(); unsigned* dn_ = (unsigned*)(ws + WS_CTL) + CW_PHDONE + 64 * (k); if (tid_opaque() == 0) __hip_atomic_fetch_add(dn_, 1u, __ATOMIC_RELAXED, __HIP_MEMORY_SCOPE_AGENT); \
        tr_slack(P, lds, (unsigned*)(ws + WS_CTL) + CW_TILE, dn_, (unsigned)G); } while (0)
    const float* mod0 = (const float*)(ws + WS_MOD); const float* mod1 = mod0 + (size_t)5 * NMOD;

#ifndef PROBE_REP
#define PROBE_REP 0
#endif
#define REPS(k) (((PROBE_REP >> (k)) & 1) ? 2 : 1)
    if (IN(0)) { MKCTX(); phase_prologue<0>(P, lds, vcu, G); if (REPS(0) == 2) phase_prologue<1>(P, lds, vcu, G); } SEAM(0);
    if (IN(1)) { MKCTX();
        { const float* mm = (const float*)(ws + WS_CTL) + CW_MOEMAX; float* mcm = (float*)(ws + WS_MCM);
          for (int i = vcu * 512 + (int)threadIdx.x; i < NEXP * 14336; i += G * 512) { const int e = i / 14336, n = i - e * 14336; mcm[i] = fmaxf(mm[2 * e + ((n >> 7) & 1)] * 1.25f, 1e-30f); } }
        phase_norm<0, 0, true>(P, 0, MT, P.in[6], 0, 1, vcu, G);
        __syncthreads(); (void)tr_run<false>(P, lds, 0, vcu, G, 0, TR_I0, nullptr, 0u); (void)tr_run<false>(P, lds, TR_I0 + TR_I1, vcu, G, 0, TR_I2, nullptr, 0u);
        (void)tr_run<false>(P, lds, TR_I0 + TR_I1 + TR_I2 + TR_I3, vcu, G, 0, TR_I4, nullptr, 0u); } SEAM(1);
    if (IN(2)) { MKCTX();
        pg8::DenseSched S{(const char*)(ws + WS_WEIN), DM / 2, DM / 2, G, bx, MT / 256, 12, 0, 0, 0, 0, DM / 128, 1};
        pg8::EpiEIn E{(bf16_t*)(ws + WS_U), (bf16_t*)(ws + WS_Z), (const float*)(ws + WS_RSC), ctlf + CW_CMAX_EIN};
        pg8::gemm_phase<pg8::EpiEIn, pg8::DenseSched, 2>(lds, (const char*)(ws + WS_HN), DM / 2, S, E);
        SLACK(2);
    } SEAM(2);
    if (IN(3)) { MKCTX(); phase_convpool(P, lds, vcu, G); } SEAM(3);
    if (IN(4)) { MKCTX();
        { pg8::DenseSched S{(const char*)(ws + WS_WEOUT), DM, DM, G, bx, ML / 256, 8, 0, 0, 0, 0, DM / 64, 1};
          pg8::EpiResT<float> E{P.in[0], P.in[2], (bf16_t*)(ws + WS_XA), mod0 + 2 * DM, 1.0f};
          pg8::gemm_phase(lds, (const char*)(ws + WS_Y0), DM, S, E); }
        { pg8::DenseSched S{(const char*)(ws + WS_WEOUT), DM, DM, G, bx, 0, 0, MC / 256, 8, ML / 256, 0, DM / 64, 4};
          pg8::EpiPart E{(float*)(ws + WS_PART), mod0 + 2 * DM, 1.0f};
          pg8::gemm_phase(lds, (const char*)(ws + WS_Y0), DM, S, E); }
        SLACK(4);
    } SEAM(4);
    if (IN(5)) { MKCTX(); phase_norm<1, 1, true>(P, 0, MT, P.in[7], 3, 4, vcu, G); } SEAM(5);
    if (IN(6)) { MKCTX();
        pg8::DenseSched S{(const char*)(ws + WS_WF1), DM / 2, DM / 2, G, bx, MT / 256, 44, 0, 0, 0, 0, DM / 128, 1};
        pg8::EpiSwiGLUi8 E{(bf16_t*)(ws + WS_ACT0), DFF, (const float*)(ws + WS_RSC), ctlf + CW_CMAX, ACTS};
        pg8::gemm_phase<pg8::EpiSwiGLUi8, pg8::DenseSched, 2>(lds, (const char*)(ws + WS_HN), DM / 2, S, E);
        if (REPS(6) == 2) pg8::gemm_phase<pg8::EpiSwiGLUi8, pg8::DenseSched, 2>(lds, (const char*)(ws + WS_HN), DM / 2, S, E);
        SLACK(6);
    } SEAM(6);
    if (IN(7)) { MKCTX();
        { pg8::DenseSched S{(const char*)(ws + WS_WF2), DFF / 2, DFF / 2, G, bx, ML / 256, 8, 0, 0, 0, 0, DFF / 128, 1};
          pg8::EpiResT<bf16_t> E{(const bf16_t*)(ws + WS_XA), (const bf16_t*)(ws + WS_XA) + (size_t)ML * DM, (bf16_t*)(ws + WS_XA), mod0 + 5 * DM, 1.0f / (W2S * ACTS)};
          pg8::gemm_phase<pg8::EpiResT<bf16_t>, pg8::DenseSched, 1>(lds, (const char*)(ws + WS_ACT0), DFF / 2, S, E); }
        { pg8::DenseSched S{(const char*)(ws + WS_WF2), DFF / 2, DFF / 2, G, bx, 0, 0, MC / 256, 8, ML / 256, 0, DFF / 128, 2};
          pg8::EpiPart E{(float*)(ws + WS_PART), mod0 + 5 * DM, 1.0f / (W2S * ACTS)};
          pg8::gemm_phase<pg8::EpiPart, pg8::DenseSched, 1>(lds, (const char*)(ws + WS_ACT0), DFF / 2, S, E); }
        SLACK(7);
    } SEAM(7);
    if (IN(8)) { MKCTX(); phase_norm<1, 2, true>(P, 1, MT, P.in[6] + DM, 0, 1, vcu, G); } SEAM(8);
    if (IN(9)) { MKCTX();
        pg8::DenseSched S{(const char*)(ws + WS_WOIN), DM / 2, DM / 2, G, bx, ML / 256, 13, MC / 256, 3, ML / 256, 2, DM / 128, 1};
        pg8::EpiOIn E{(bf16_t*)(ws + WS_CQ), (bf16_t*)(ws + WS_CKV), (bf16_t*)(ws + WS_GU), (bf16_t*)(ws + WS_GV), ws + WS_K, ctlf + CW_SSQQ, ctlf + CW_SSQKV, ctlf + CW_ZS1, ctlf + CW_ZS2, (const float*)(ws + WS_ROPE), (const float*)(ws + WS_RSC), ctlf + CW_CMAX_OIN};
        pg8::gemm_phase<pg8::EpiOIn, pg8::DenseSched, 2>(lds, (const char*)(ws + WS_HN), DM / 2, S, E);
        SLACK(9);
    } SEAM(9);
    if (IN(10)) { MKCTX();
        { pg8::QKVSched S{(const char*)(ws + WS_WQB), (const char*)(ws + WS_WKVB), (unsigned)(WS_CKV - WS_CQ), 512, 512, G, bx};
          pg8::EpiQKV E{pg8::EpiQ{ws + WS_Q, ctlf + CW_SSQQ, (const float*)(ws + WS_ROPE)}, pg8::EpiKV{ws + WS_K, ws + WS_V, ctlf + CW_SSQKV}};
          pg8::gemm_phase(lds, (const char*)(ws + WS_CQ), 512, S, E); }
        phase_sgu(P, lds, vcu, G);
        SLACK(10);
    } SEAM(10);
    if (IN(11)) { MKCTX();
        const unsigned char* Qb = ws + WS_Q; const unsigned char* Kb = ws + WS_K; const unsigned char* Vb = ws + WS_V; bf16_t* CAT = (bf16_t*)(ws + WS_Y0);
        for (int rp = 0; rp < REPS(11); ++rp)
        for (int un = vcu; un < NB * 8 * 16; un += G) {
            const int qb = un & 15, bh = un >> 4, h = bh & 7, b = bh >> 3;
            __syncthreads();
            att::attn_body(Qb + ((size_t)(b * SEQ + qb * 256) * 1536 + h * 192), Kb + ((size_t)b * KVL * 1536 + h * 192), Vb + (size_t)(b * 8 + h) * 128 * KVL,
                           CAT + ((size_t)(b * SEQ + qb * 256) * DM + h * 128), KVL, (char*)lds_raw);
        }
    } SEAM(11);
    if (IN(12)) { MKCTX();
        pg8::DenseSched S{(const char*)(ws + WS_WOOUT), DM, DM, G, bx, ML / 256, 8, 0, 0, 0, 0, DM / 64, 1};
        pg8::EpiResT<bf16_t> E{(const bf16_t*)(ws + WS_XA), (const bf16_t*)(ws + WS_XA) + (size_t)ML * DM, (bf16_t*)(ws + WS_XA), mod1 + 2 * DM, 1.0f};
        pg8::gemm_phase(lds, (const char*)(ws + WS_Y0), DM, S, E);
    } SEAM(12);
    if (IN(13)) { MKCTX();
        if (vcu & 1) { phase_router(P, lds, vcu, G); __syncthreads(); tr_slack(P, lds, (unsigned*)(ws + WS_CTL) + CW_TILE, nullptr, 0u); }
        else { tr_slack(P, lds, (unsigned*)(ws + WS_CTL) + CW_TILE, nullptr, 0u); __syncthreads(); phase_router(P, lds, vcu, G); } } SEAM(13);
    if (IN(14)) { MKCTX();
        moe_tables(P, tab, 56);
        pg8::MoeSched S{(const char*)(ws + WS_WM1), (const int*)(ws + WS_LIST), tab, DM / 2, DM / 2, G, bx, 56, 1, (size_t)14336 * DM, DM / 128};
        pg8::EpiSwiGLUi8M E{ws + WS_ACT1, DFFE, (const float*)(ws + WS_MRS), (const float*)(ws + WS_MCM), ACTS};
        pg8::gemm_phase<pg8::EpiSwiGLUi8M, pg8::MoeSched, 2>(lds, (const char*)(ws + WS_HNP), DM / 2, S, E);
        if (REPS(14) == 2) pg8::gemm_phase<pg8::EpiSwiGLUi8M, pg8::MoeSched, 2>(lds, (const char*)(ws + WS_HNP), DM / 2, S, E);
    } SEAM(14);
    if (IN(15)) { MKCTX();
        moe_tables(P, tab, 8);
        pg8::MoeSched S{(const char*)(ws + WS_WM2), (const int*)(ws + WS_LIST), tab, DFFE / 2, DFFE / 2, G, bx, 8, 0, (size_t)DM * DFFE, DFFE / 128};
        pg8::EpiBf16 E{(bf16_t*)(ws + WS_YB), DM, 1.0f / (W2S * ACTS)};
        pg8::gemm_phase<pg8::EpiBf16, pg8::MoeSched, 1>(lds, (const char*)(ws + WS_ACT1), DFFE / 2, S, E);
        if (REPS(15) == 2) pg8::gemm_phase<pg8::EpiBf16, pg8::MoeSched, 1>(lds, (const char*)(ws + WS_ACT1), DFFE / 2, S, E);
    } SEAM(15);
    if (IN(16)) { MKCTX(); moe_tables(P, tab, 8); phase_final(P, tab, vcu, G); }
#undef IN
#undef SEAM
}

#ifndef MK_PER_PHASE
#define MK_PER_PHASE 0
#endif
extern "C" void kernel_launch(void* const* d_in, const int* in_sizes, int n_in, void* d_out, int out_size, void* d_ws, size_t ws_size, hipStream_t stream) {
    static int grid = 0;
    if (grid == 0) {
        if (n_in != 35 || out_size != ML * DM || ws_size < WS_END) { fprintf(stderr, "kernel_launch: unexpected shapes: n_in %d out %d ws %zu (need %zu)\n", n_in, out_size, ws_size, (size_t)WS_END); grid = -1; return; }
        int dev = 0, cus = 0, per_cu = 0;
        if (hipGetDevice(&dev) != hipSuccess || hipDeviceGetAttribute(&cus, hipDeviceAttributeMultiprocessorCount, dev) != hipSuccess) { grid = -1; return; }
        if (hipFuncSetAttribute((const void*)fwd_kernel, hipFuncAttributeMaxDynamicSharedMemorySize, LDS_BYTES) != hipSuccess) { fprintf(stderr, "kernel_launch: hipFuncSetAttribute failed\n"); grid = -1; return; }
        if (hipOccupancyMaxActiveBlocksPerMultiprocessor(&per_cu, (const void*)fwd_kernel, 512, LDS_BYTES) != hipSuccess || per_cu < 1) fprintf(stderr, "kernel_launch: occupancy query says %d\n", per_cu);
        (void)hipGetLastError();
        grid = cus;
    }
    if (grid < 0) return;
    static_assert((CW_MOEMAX + 16) * 4 <= (512 << 10) && (CW_CMAX_OIN + 3328) * 4 <= (512 << 10), "control words in use must lie inside the zeroed half");
    (void)hipMemsetAsync((char*)d_ws + WS_CTL, 0, (size_t)512 << 10, stream);
    Params p; memset(&p, 0, sizeof(p));
    for (int i = 0; i < 35; ++i) p.in[i] = (const float*)d_in[i];
    p.out = (float*)d_out; p.ws = (unsigned char*)d_ws; p.grid = grid;
#if MK_PER_PHASE
    for (int k = 0; k < NPHASE; ++k) { p.ph_lo = k; p.ph_hi = k + 1; p.use_bar = 0; hipLaunchKernelGGL(fwd_kernel, dim3(grid), dim3(512), LDS_BYTES, stream, p); }
#else
    p.ph_lo = 0; p.ph_hi = NPHASE; p.use_bar = 1;
    hipLaunchKernelGGL(fwd_kernel, dim3(grid), dim3(512), LDS_BYTES, stream, p);
#endif
    const hipError_t le = hipPeekAtLastError();
    if (le != hipSuccess) fprintf(stderr, "kernel_launch: launch failed: %s\n", hipGetErrorName(le));
}
```
